# Optimizing an MI355X kernel written in HIP

```python
import math
import jax
import jax.numpy as jnp
from jax import lax
import numpy as np

D_MODEL = 1024
BATCH = 1
SEQ = 16384
DEPTH = 4

N_META = 16
A_HEADS = 4
A_QK_DIM = 64
A_V_DIM = 2 * A_QK_DIM
A_QK_WIDTH = 2 * A_HEADS * A_QK_DIM
A_WIDTH = A_HEADS * A_V_DIM
Q_BLOCK = 128
REL_BUCKETS = 32
REL_MAX_DIST = 128
POOL_WINDOWS = (2, 4, 8, 16)
B_GROUPS = len(POOL_WINDOWS)
B_WIDTH = D_MODEL - A_WIDTH
B_GROUP_DIM = B_WIDTH // B_GROUPS
EVEN_IN = 2 * A_QK_WIDTH + A_WIDTH + B_WIDTH
C_HEADS = 8
C_HEAD_DIM = D_MODEL // C_HEADS
C_WIDTH = C_HEADS * C_HEAD_DIM
CONV_WIDTH = 4
CHUNK = 64
ODD_IN = 4 * C_WIDTH + 2 * C_HEADS
D_FF = 4 * D_MODEL
ALPHA = (2.0 * DEPTH) ** 0.25
BETA_INIT = (8.0 * DEPTH) ** -0.25
N_EVEN = (DEPTH + 1) // 2
N_ODD = DEPTH // 2
LN_EPS = 1e-5
RMS_EPS = 1e-6

kernel_name = 'hybrid_diffattn_pool_gdn_deepnorm'


def layer_norm(x, g, b):
    xf = x.astype(jnp.float32)
    mu = jnp.mean(xf, axis=-1, keepdims=True)
    xc = xf - mu
    var = jnp.mean(xc * xc, axis=-1, keepdims=True)
    y = xc * lax.rsqrt(var + LN_EPS) * g.astype(jnp.float32) + b.astype(jnp.float32)
    return y.astype(x.dtype)


def rms_norm(x, w):
    xf = x.astype(jnp.float32)
    return xf * lax.rsqrt(jnp.mean(xf * xf, axis=-1, keepdims=True) + RMS_EPS) * w.astype(jnp.float32)


def l2_normalize(x):
    xf = x.astype(jnp.float32)
    return xf * lax.rsqrt(jnp.sum(xf * xf, axis=-1, keepdims=True) + RMS_EPS)


def t5_causal_bucket(q_pos, k_pos):
    n = jnp.maximum(q_pos[:, None] - k_pos[None, :], 0)
    max_exact = REL_BUCKETS // 2
    nf = jnp.maximum(n, 1).astype(jnp.float32)
    large = max_exact + (jnp.log(nf / max_exact) / math.log(REL_MAX_DIST / max_exact)
                         * (REL_BUCKETS - max_exact)).astype(jnp.int32)
    large = jnp.minimum(large, REL_BUCKETS - 1)
    return jnp.where(n < max_exact, n, large)


def diff_attention(q, k, v, lam, rel_bias):
    bsz, heads, _, length, _ = q.shape
    n_blocks = -(-length // Q_BLOCK)
    padded = n_blocks * Q_BLOCK
    q_pad = jnp.pad(q, ((0, 0), (0, 0), (0, 0), (0, padded - length), (0, 0)))
    k_pos = jnp.arange(length)
    scale = A_QK_DIM ** -0.5

    def one_block(i):
        start = i * Q_BLOCK
        qb = lax.dynamic_slice_in_dim(q_pad, start, Q_BLOCK, axis=3)
        q_pos = start + jnp.arange(Q_BLOCK)
        bias = jnp.transpose(rel_bias[t5_causal_bucket(q_pos, k_pos)], (2, 0, 1)).astype(jnp.float32)
        s = jnp.einsum('bhcqd,bhckd->bhcqk', qb, k).astype(jnp.float32) * scale + bias[None, :, None]
        s = jnp.where(k_pos[None, :] <= q_pos[:, None], s, -jnp.inf)
        p = jax.nn.softmax(s, axis=-1)
        a = p[:, :, 0] - lam * p[:, :, 1]
        return jnp.einsum('bhqk,bhkd->bhqd', a.astype(v.dtype), v)

    o = lax.map(one_block, jnp.arange(n_blocks))
    o = jnp.transpose(o, (1, 0, 3, 2, 4)).reshape(bsz, padded, heads, A_V_DIM)
    return o[:, :length]


def pool_mixer(u, pool_w, pool_scale):
    bsz, length, _ = u.shape
    ug = u.astype(jnp.float32).reshape(bsz, length, B_GROUPS, B_GROUP_DIM)
    cs = jnp.cumsum(ug, axis=1)
    t = jnp.arange(length)
    outs = []
    for gi, win in enumerate(POOL_WINDOWS):
        c = cs[:, :, gi]
        prev = jnp.pad(c, ((0, 0), (win, 0), (0, 0)))[:, :length]
        cnt = jnp.minimum(t + 1, win).astype(jnp.float32)[None, :, None]
        outs.append((c - prev) / cnt - ug[:, :, gi])
    pooled = jnp.stack(outs, axis=2).astype(u.dtype)
    y = jnp.einsum('blgc,gcd->blgd', pooled, pool_w).reshape(bsz, length, B_WIDTH)
    return y * pool_scale


def even_mixer(x, w_in, lam_vecs, subln_w, pool_w, pool_scale, w_out, lambda_init, rel_bias):
    bsz, length, _ = x.shape
    h = x @ w_in
    q = h[..., :A_QK_WIDTH]
    k = h[..., A_QK_WIDTH:2 * A_QK_WIDTH]
    v = h[..., 2 * A_QK_WIDTH:2 * A_QK_WIDTH + A_WIDTH]
    u = h[..., 2 * A_QK_WIDTH + A_WIDTH:]
    q = q.reshape(bsz, length, A_HEADS, 2, A_QK_DIM).transpose(0, 2, 3, 1, 4)
    k = k.reshape(bsz, length, A_HEADS, 2, A_QK_DIM).transpose(0, 2, 3, 1, 4)
    v = v.reshape(bsz, length, A_HEADS, A_V_DIM).transpose(0, 2, 1, 3)
    lv = lam_vecs.astype(jnp.float32)
    lam = jnp.exp(jnp.sum(lv[0] * lv[1])) - jnp.exp(jnp.sum(lv[2] * lv[3])) + lambda_init
    o = diff_attention(q, k, v, lam, rel_bias)
    o = (rms_norm(o, subln_w) * (1.0 - lambda_init)).astype(x.dtype).reshape(bsz, length, A_WIDTH)
    y_pool = pool_mixer(u, pool_w, pool_scale)
    return jnp.concatenate([o, y_pool.astype(x.dtype)], axis=-1) @ w_out


def causal_depthwise_conv(x, w):
    ch = x.shape[-1]
    y = lax.conv_general_dilated(jnp.swapaxes(x, 1, 2), w[:, None, :].astype(x.dtype),
                                 window_strides=(1,), padding=[(CONV_WIDTH - 1, 0)],
                                 dimension_numbers=('NCH', 'OIH', 'NCH'), feature_group_count=ch)
    return jnp.swapaxes(y, 1, 2)


def gated_delta_chunked(q, k, v, g, beta):
    bsz, length, heads, dk = q.shape
    dv = v.shape[-1]
    lead = (-N_META) % CHUNK
    total = lead + length
    tail = (-total) % CHUNK
    n_chunks = (total + tail) // CHUNK

    def prep(t):
        t = jnp.moveaxis(t, 2, 1)
        pad = [(0, 0), (0, 0), (lead, tail)] + [(0, 0)] * (t.ndim - 3)
        t = jnp.pad(t, pad)
        return t.reshape(bsz, heads, n_chunks, CHUNK, *t.shape[3:])

    q, k, v, g, beta = (prep(t) for t in (q, k, v, g, beta))
    q = q * (dk ** -0.5)
    g = jnp.cumsum(g, axis=-1)
    idx = jnp.arange(CHUNK)
    causal = idx[:, None] >= idx[None, :]
    strict = idx[:, None] > idx[None, :]
    decay = jnp.exp(jnp.where(causal, g[..., :, None] - g[..., None, :], -jnp.inf))
    k_beta = k * beta[..., None]
    lower = jnp.where(strict, jnp.einsum('bhncd,bhnsd->bhncs', k_beta, k) * decay, 0.0)
    eye = jnp.eye(CHUNK, dtype=jnp.float32)
    rhs = jnp.concatenate([v * beta[..., None], k_beta * jnp.exp(g)[..., None]], axis=-1)
    sol = lax.linalg.triangular_solve(eye + lower, rhs, left_side=True, lower=True, unit_diagonal=True)
    u, w = sol[..., :dv], sol[..., dv:]
    qk = jnp.where(causal, jnp.einsum('bhncd,bhnsd->bhncs', q, k) * decay, 0.0)

    def step(state, inp):
        q_c, k_c, u_c, w_c, g_c, qk_c = inp
        v_new = u_c - jnp.einsum('bhck,bhkv->bhcv', w_c, state)
        o_c = (jnp.einsum('bhck,bhkv->bhcv', q_c * jnp.exp(g_c)[..., None], state)
               + jnp.einsum('bhcs,bhsv->bhcv', qk_c, v_new))
        g_last = g_c[..., -1]
        k_dec = k_c * jnp.exp(g_last[..., None] - g_c)[..., None]
        state = state * jnp.exp(g_last)[..., None, None] + jnp.einsum('bhck,bhcv->bhkv', k_dec, v_new)
        return state, o_c

    xs = tuple(jnp.moveaxis(t, 2, 0) for t in (q, k, u, w, g, qk))
    state0 = jnp.zeros((bsz, heads, dk, dv), jnp.float32)
    _, o = lax.scan(step, state0, xs)
    o = jnp.moveaxis(o, 0, 2).reshape(bsz, heads, n_chunks * CHUNK, dv)[:, :, lead:lead + length]
    return jnp.moveaxis(o, 1, 2)


def odd_mixer(x, w_in, conv_w, a_log, dt_bias, norm_w, w_out):
    bsz, length, _ = x.shape
    h = x @ w_in
    qkv = jax.nn.silu(causal_depthwise_conv(h[..., :3 * C_WIDTH], conv_w))
    z = h[..., 3 * C_WIDTH:4 * C_WIDTH]
    b_raw = h[..., 4 * C_WIDTH:4 * C_WIDTH + C_HEADS].astype(jnp.float32)
    a_raw = h[..., 4 * C_WIDTH + C_HEADS:].astype(jnp.float32)

    def heads(t):
        return t.reshape(bsz, length, C_HEADS, C_HEAD_DIM)

    q = l2_normalize(heads(qkv[..., :C_WIDTH]))
    k = l2_normalize(heads(qkv[..., C_WIDTH:2 * C_WIDTH]))
    v = heads(qkv[..., 2 * C_WIDTH:]).astype(jnp.float32)
    beta = jax.nn.sigmoid(b_raw)
    g = -jnp.exp(a_log.astype(jnp.float32)) * jax.nn.softplus(a_raw + dt_bias.astype(jnp.float32))
    o = gated_delta_chunked(q, k, v, g, beta)
    o = rms_norm(o, norm_w) * jax.nn.silu(heads(z).astype(jnp.float32))
    return o.reshape(bsz, length, C_WIDTH).astype(x.dtype) @ w_out


def sqrelu_mlp(x, w1, w2):
    return jnp.square(jax.nn.relu(x @ w1)) @ w2


def setup_inputs(seed: int = 0) -> dict:
    key = jax.random.key(seed)
    ks = jax.random.split(key, 24)
    f32 = jnp.float32

    def nrm(k, shape, scale):
        return jax.random.normal(k, shape, f32) * scale

    x = nrm(ks[0], (BATCH, SEQ, D_MODEL), 1.0)
    meta_tokens = nrm(ks[1], (N_META, D_MODEL), 1.0)
    rel_bias = nrm(ks[2], (REL_BUCKETS, A_HEADS), 0.5)
    ev_w_in = nrm(ks[3], (N_EVEN, D_MODEL, EVEN_IN), D_MODEL ** -0.5)
    ev_lambda = nrm(ks[4], (N_EVEN, 4, A_QK_DIM), 0.1)
    ev_subln_w = 1.0 + nrm(ks[5], (N_EVEN, A_V_DIM), 0.02)
    ev_pool_w = nrm(ks[6], (N_EVEN, B_GROUPS, B_GROUP_DIM, B_GROUP_DIM), B_GROUP_DIM ** -0.5)
    ev_pool_scale = 1.0 + nrm(ks[7], (N_EVEN, B_WIDTH), 0.02)
    ev_w_out = nrm(ks[8], (N_EVEN, D_MODEL, D_MODEL), BETA_INIT * D_MODEL ** -0.5)
    od_w_in = nrm(ks[9], (N_ODD, D_MODEL, ODD_IN), D_MODEL ** -0.5)
    od_conv_w = nrm(ks[10], (N_ODD, 3 * C_WIDTH, CONV_WIDTH), CONV_WIDTH ** -0.5)
    od_a_log = jnp.log(jax.random.uniform(ks[11], (N_ODD, C_HEADS), f32, 1.0, 16.0))
    dt = jnp.exp(jax.random.uniform(ks[12], (N_ODD, C_HEADS), f32, math.log(1e-3), math.log(1e-1)))
    od_dt_bias = dt + jnp.log(-jnp.expm1(-dt))
    od_norm_w = 1.0 + nrm(ks[13], (N_ODD, C_HEAD_DIM), 0.02)
    od_w_out = nrm(ks[14], (N_ODD, C_WIDTH, D_MODEL), BETA_INIT * C_WIDTH ** -0.5)
    mlp_w1 = nrm(ks[15], (DEPTH, D_MODEL, D_FF), D_MODEL ** -0.5)
    mlp_w2 = nrm(ks[16], (DEPTH, D_FF, D_MODEL), BETA_INIT * D_FF ** -0.5)
    ln_mix_g = 1.0 + nrm(ks[17], (DEPTH, D_MODEL), 0.02)
    ln_mix_b = nrm(ks[18], (DEPTH, D_MODEL), 0.02)
    ln_mlp_g = 1.0 + nrm(ks[19], (DEPTH, D_MODEL), 0.02)
    ln_mlp_b = nrm(ks[20], (DEPTH, D_MODEL), 0.02)
    return {'x': x, 'meta_tokens': meta_tokens, 'rel_bias': rel_bias,
            'ev_w_in': ev_w_in, 'ev_lambda': ev_lambda, 'ev_subln_w': ev_subln_w,
            'ev_pool_w': ev_pool_w, 'ev_pool_scale': ev_pool_scale, 'ev_w_out': ev_w_out,
            'od_w_in': od_w_in, 'od_conv_w': od_conv_w, 'od_a_log': od_a_log,
            'od_dt_bias': od_dt_bias, 'od_norm_w': od_norm_w, 'od_w_out': od_w_out,
            'mlp_w1': mlp_w1, 'mlp_w2': mlp_w2,
            'ln_mix_g': ln_mix_g, 'ln_mix_b': ln_mix_b, 'ln_mlp_g': ln_mlp_g, 'ln_mlp_b': ln_mlp_b}


def reference(x, meta_tokens, rel_bias, ev_w_in, ev_lambda, ev_subln_w, ev_pool_w, ev_pool_scale,
              ev_w_out, od_w_in, od_conv_w, od_a_log, od_dt_bias, od_norm_w, od_w_out,
              mlp_w1, mlp_w2, ln_mix_g, ln_mix_b, ln_mlp_g, ln_mlp_b):
    bsz = x.shape[0]
    meta = jnp.broadcast_to(meta_tokens[None].astype(x.dtype), (bsz, N_META, D_MODEL))
    h = jnp.concatenate([meta, x], axis=1)
    for i in range(DEPTH):
        j = i // 2
        if i % 2 == 0:
            lambda_init = 0.8 - 0.6 * math.exp(-0.3 * i)
            mix = even_mixer(h, ev_w_in[j], ev_lambda[j], ev_subln_w[j], ev_pool_w[j],
                             ev_pool_scale[j], ev_w_out[j], lambda_init, rel_bias)
        else:
            mix = odd_mixer(h, od_w_in[j], od_conv_w[j], od_a_log[j], od_dt_bias[j],
                            od_norm_w[j], od_w_out[j])
        h = layer_norm(ALPHA * h + mix, ln_mix_g[i], ln_mix_b[i])
        h = layer_norm(ALPHA * h + sqrelu_mlp(h, mlp_w1[i], mlp_w2[i]), ln_mlp_g[i], ln_mlp_b[i])
    return h[:, N_META:]
```

```cpp
#include <hip/hip_runtime.h>
#include <hip/hip_cooperative_groups.h>
namespace cg = cooperative_groups;

typedef unsigned short bf16_t;
using bf16x8 = __attribute__((ext_vector_type(8))) short;
using f32x4 = __attribute__((ext_vector_type(4))) float;
using u32x4 = __attribute__((ext_vector_type(4))) unsigned;
using u32x2 = __attribute__((ext_vector_type(2))) unsigned;
typedef __bf16 bf2_t __attribute__((ext_vector_type(2)));
typedef float f2_t __attribute__((ext_vector_type(2)));

#define DEVI __device__ __forceinline__
#define GLOBAL_AS __attribute__((address_space(1)))

DEVI int opaque_tid() { int t = threadIdx.x; asm volatile("" : "+v"(t)); return t; }
DEVI int opaque_bid() { int b = blockIdx.x; asm volatile("" : "+s"(b)); return b; }
#define TIDX opaque_tid()
#define BIDX opaque_bid()

constexpr int L = 16400;
constexpr int LR = 16512;
constexpr int NMT = 129;
constexpr int NCH = 257;
constexpr float ALPHA = 1.6817928305074290f;
constexpr float LOG2E = 1.4426950408889634f;

constexpr size_t OFF_HB = 0;
constexpr size_t OFF_WB = 33816576;
constexpr size_t OFF_METAH = 61341696;
constexpr size_t OFF_MISC = 61407232;
constexpr size_t OFF_BA = 61411328;
constexpr size_t OFF_R0 = 62468096;
constexpr size_t OFF_R1 = 163917824;
constexpr size_t OFF_BAR = 265367552;
constexpr size_t WB_IN = 0, WB_Z = 3276800, WB_OUT = 4325376, WB_W1 = 5373952, WB_W2 = 9568256;
constexpr size_t R0_Q = 0, R0_K = 8454144, R0_VT = 16908288, R0_U = 25362432;
constexpr size_t R0_KT = 0, R0_QK = 16842752, R0_G = 25264128, R0_Z = 26100000;

constexpr int SMEM_BYTES = 73728 + 1024;

struct Params {
  const float* in[21];
  float* out;
  char* ws;
};

DEVI unsigned pack2(float a, float b) {
  f2_t v = {a, b};
  bf2_t r = __builtin_convertvector(v, bf2_t);
  return __builtin_bit_cast(unsigned, r);
}
DEVI bf16_t f2bf(float a) { return (bf16_t)(pack2(a, 0.f) & 0xffff); }
DEVI float bf2f(bf16_t b) { return __uint_as_float(((unsigned)b) << 16); }
DEVI float bflo(unsigned u) { return __uint_as_float(u << 16); }
DEVI float bfhi(unsigned u) { return __uint_as_float(u & 0xffff0000u); }

DEVI float* hfrow(const Params& p, int t) {
  return t < 16 ? (float*)(p.ws + OFF_METAH) + t * 1024 : p.out + (size_t)(t - 16) * 1024;
}
DEVI float wave_sum(float v) {
#pragma unroll
  for (int m = 32; m >= 1; m >>= 1) v += __shfl_xor(v, m);
  return v;
}
DEVI bf16x8 mk8(u32x2 a, u32x2 b) {
  u32x4 r = {a.x, a.y, b.x, b.y};
  return __builtin_bit_cast(bf16x8, r);
}
DEVI bf16x8 pack8(f32x4 a, f32x4 b) {
  u32x4 r = {pack2(a[0], a[1]), pack2(a[2], a[3]), pack2(b[0], b[1]), pack2(b[2], b[3])};
  return __builtin_bit_cast(bf16x8, r);
}
DEVI size_t wfm(int n, int k, int K) {
  return ((size_t)(n >> 4) * (K >> 5) + (k >> 5)) * 512 + ((((k >> 3) & 3) << 4) + (n & 15)) * 8 + (k & 7);
}
#define MFMA16(a, b, c) __builtin_amdgcn_mfma_f32_16x16x32_bf16((a), (b), (c), 0, 0, 0)

template <class Epi>
DEVI void gemm_tile(const bf16_t* __restrict__ A, int lda, const bf16_t* __restrict__ Bt, int K,
                    int m0, int n0, char* smem, Epi epi) {
  const int tid = TIDX, lane = tid & 63, wave = tid >> 6;
  const int wm = wave >> 1, wn = wave & 1, l15 = lane & 15, quad = lane >> 4;
  f32x4 acc[4][4];
#pragma unroll
  for (int i = 0; i < 4; ++i)
#pragma unroll
    for (int j = 0; j < 4; ++j) acc[i][j] = f32x4{0.f, 0.f, 0.f, 0.f};
  const int lrow = tid >> 3, lkc = tid & 7;
  const bf16_t* ag = A + (size_t)(m0 + lrow) * lda + lkc * 8;
  const bf16_t* bg = Bt + (size_t)(n0 + lrow) * K + lkc * 8;
  u32x4 ra[4], rb[4];
#pragma unroll
  for (int i = 0; i < 4; ++i) {
    ra[i] = *(const u32x4*)(ag + (size_t)(i * 32) * lda);
    rb[i] = *(const u32x4*)(bg + (size_t)(i * 32) * K);
  }
  const int lds_w = lrow * 128 + ((lkc ^ (lrow & 7)) << 4);
#pragma unroll
  for (int i = 0; i < 4; ++i) {
    *(u32x4*)(smem + lds_w + i * 4096) = ra[i];
    *(u32x4*)(smem + 16384 + lds_w + i * 4096) = rb[i];
  }
  __syncthreads();
  const int nk = K >> 6;
  const int sw = (quad ^ (l15 & 7)) << 4;
  const int a_rd = (wm * 64 + l15) * 128 + sw;
  const int b_rd = 16384 + (wn * 64 + l15) * 128 + sw;
  for (int kt = 0; kt < nk; ++kt) {
    const int buf = (kt & 1) * 32768;
    if (kt + 1 < nk) {
#pragma unroll
      for (int i = 0; i < 4; ++i) {
        ra[i] = *(const u32x4*)(ag + (size_t)(i * 32) * lda + (kt + 1) * 64);
        rb[i] = *(const u32x4*)(bg + (size_t)(i * 32) * K + (kt + 1) * 64);
      }
    }
#pragma unroll
    for (int ks = 0; ks < 2; ++ks) {
      bf16x8 af[4], bf[4];
#pragma unroll
      for (int i = 0; i < 4; ++i) {
        af[i] = *(const bf16x8*)(smem + buf + ((a_rd + i * 2048) ^ (ks * 64)));
        bf[i] = *(const bf16x8*)(smem + buf + ((b_rd + i * 2048) ^ (ks * 64)));
      }
#pragma unroll
      for (int mi = 0; mi < 4; ++mi)
#pragma unroll
        for (int ni = 0; ni < 4; ++ni) acc[mi][ni] = MFMA16(bf[ni], af[mi], acc[mi][ni]);
    }
    if (kt + 1 < nk) {
      const int nb = ((kt + 1) & 1) * 32768;
#pragma unroll
      for (int i = 0; i < 4; ++i) {
        *(u32x4*)(smem + nb + lds_w + i * 4096) = ra[i];
        *(u32x4*)(smem + nb + 16384 + lds_w + i * 4096) = rb[i];
      }
    }
    __syncthreads();
  }
#pragma unroll
  for (int mi = 0; mi < 4; ++mi)
#pragma unroll
    for (int ni = 0; ni < 4; ++ni)
      epi(m0 + wm * 64 + mi * 16 + l15, n0 + wn * 64 + ni * 16 + quad * 4, acc[mi][ni]);
}

template <class Epi>
DEVI void gemm_tile256(const bf16_t* __restrict__ A, int lda, const bf16_t* __restrict__ Bt, int K,
                       int m0, int n0, char* smem, Epi epi) {
  const int tid = TIDX, lane = tid & 63, wave = tid >> 6;
  const int wm = wave >> 1, wn = wave & 1, l15 = lane & 15, quad = lane >> 4;
  f32x4 acc[8][4];
#pragma unroll
  for (int i = 0; i < 8; ++i)
#pragma unroll
    for (int j = 0; j < 4; ++j) acc[i][j] = f32x4{0.f, 0.f, 0.f, 0.f};
  const int lrow = tid >> 3, lkc = tid & 7;
  const bf16_t* ag = A + (size_t)(m0 + lrow) * lda + lkc * 8;
  const bf16_t* bg = Bt + (size_t)(n0 + lrow) * K + lkc * 8;
  u32x4 ra[8], rb[4];
  auto gload = [&](int kt) {
#pragma unroll
    for (int i = 0; i < 8; ++i) ra[i] = *(const u32x4*)(ag + (size_t)(i * 32) * lda + kt * 64);
#pragma unroll
    for (int i = 0; i < 4; ++i) rb[i] = *(const u32x4*)(bg + (size_t)(i * 32) * K + kt * 64);
  };
  const int lds_w = lrow * 128 + ((lkc ^ (lrow & 7)) << 4);
  const int nk = K >> 6;
  const int sw = (quad ^ (l15 & 7)) << 4;
  const int a_rd = (wm * 128 + l15) * 128 + sw;
  const int b_rd = 32768 + (wn * 64 + l15) * 128 + sw;
  gload(0);
  for (int kt = 0; kt < nk; ++kt) {
#pragma unroll
    for (int i = 0; i < 8; ++i) *(u32x4*)(smem + lds_w + i * 4096) = ra[i];
#pragma unroll
    for (int i = 0; i < 4; ++i) *(u32x4*)(smem + 32768 + lds_w + i * 4096) = rb[i];
    __syncthreads();
    if (kt + 1 < nk) gload(kt + 1);
#pragma unroll
    for (int ks = 0; ks < 2; ++ks) {
      bf16x8 af[8], bf[4];
#pragma unroll
      for (int i = 0; i < 4; ++i) bf[i] = *(const bf16x8*)(smem + ((b_rd + i * 2048) ^ (ks * 64)));
#pragma unroll
      for (int i = 0; i < 8; ++i) af[i] = *(const bf16x8*)(smem + ((a_rd + i * 2048) ^ (ks * 64)));
#pragma unroll
      for (int mi = 0; mi < 8; ++mi)
#pragma unroll
        for (int ni = 0; ni < 4; ++ni) acc[mi][ni] = MFMA16(bf[ni], af[mi], acc[mi][ni]);
    }
    __syncthreads();
  }
#pragma unroll
  for (int mi = 0; mi < 8; ++mi)
#pragma unroll
    for (int ni = 0; ni < 4; ++ni)
      epi(m0 + wm * 128 + mi * 16 + l15, n0 + wn * 64 + ni * 16 + quad * 4, acc[mi][ni]);
}

template <class Epi>
DEVI void gemm_tile256b(const bf16_t* __restrict__ A, int lda, const bf16_t* __restrict__ Bt, int K,
                        int m0, int n0, char* smem, Epi epi) {
  const int tid = TIDX, lane = tid & 63, wave = tid >> 6;
  const int wm = wave >> 1, wn = wave & 1, l15 = lane & 15, quad = lane >> 4;
  f32x4 acc[8][4];
#pragma unroll
  for (int i = 0; i < 8; ++i)
#pragma unroll
    for (int j = 0; j < 4; ++j) acc[i][j] = f32x4{0.f, 0.f, 0.f, 0.f};
  const int lrow = tid >> 3, lkc = tid & 7;
  const bf16_t* ag = A + (size_t)(m0 + lrow) * lda + lkc * 8;
  const int kb32 = K >> 5;
  const bf16_t* bp = Bt + ((size_t)((n0 + wn * 64) >> 4) * kb32) * 512 + lane * 8;
  u32x4 ra[8];
  bf16x8 b0[4], b1[4];
  const int lds_w = lrow * 128 + ((lkc ^ (lrow & 7)) << 4);
  const int nk = K >> 6;
  const int sw = (quad ^ (l15 & 7)) << 4;
  const int a_rd = (wm * 128 + l15) * 128 + sw;
#pragma unroll
  for (int i = 0; i < 8; ++i) ra[i] = *(const u32x4*)(ag + (size_t)(i * 32) * lda);
#pragma unroll
  for (int i = 0; i < 4; ++i) b0[i] = *(const bf16x8*)(bp + ((size_t)i * kb32) * 512);
#pragma unroll
  for (int i = 0; i < 8; ++i) *(u32x4*)(smem + lds_w + i * 4096) = ra[i];
  __syncthreads();
  for (int kt = 0; kt < nk; ++kt) {
    const char* base = smem + (kt & 1) * 32768;
    const bool more = kt + 1 < nk;
    if (more) {
#pragma unroll
      for (int i = 0; i < 8; ++i) ra[i] = *(const u32x4*)(ag + (size_t)(i * 32) * lda + (kt + 1) * 64);
    }
#pragma unroll
    for (int i = 0; i < 4; ++i) b1[i] = *(const bf16x8*)(bp + ((size_t)i * kb32 + kt * 2 + 1) * 512);
    {
      bf16x8 af[8];
#pragma unroll
      for (int i = 0; i < 8; ++i) af[i] = *(const bf16x8*)(base + a_rd + i * 2048);
#pragma unroll
      for (int mi = 0; mi < 8; ++mi)
#pragma unroll
        for (int ni = 0; ni < 4; ++ni) acc[mi][ni] = MFMA16(b0[ni], af[mi], acc[mi][ni]);
    }
    if (more) {
#pragma unroll
      for (int i = 0; i < 4; ++i) b0[i] = *(const bf16x8*)(bp + ((size_t)i * kb32 + kt * 2 + 2) * 512);
    }
    {
      bf16x8 af[8];
#pragma unroll
      for (int i = 0; i < 8; ++i) af[i] = *(const bf16x8*)(base + ((a_rd + i * 2048) ^ 64));
#pragma unroll
      for (int mi = 0; mi < 8; ++mi)
#pragma unroll
        for (int ni = 0; ni < 4; ++ni) acc[mi][ni] = MFMA16(b1[ni], af[mi], acc[mi][ni]);
    }
    if (more) {
      char* nb = smem + ((kt + 1) & 1) * 32768 + lds_w;
#pragma unroll
      for (int i = 0; i < 8; ++i) *(u32x4*)(nb + i * 4096) = ra[i];
    }
    __syncthreads();
  }
#pragma unroll
  for (int mi = 0; mi < 8; ++mi)
#pragma unroll
    for (int ni = 0; ni < 4; ++ni)
      epi(m0 + wm * 128 + mi * 16 + l15, n0 + wn * 64 + ni * 16 + quad * 4, acc[mi][ni]);
}

template <class Epi>
DEVI void gemm_tail_tile(const bf16_t* __restrict__ A, int lda, const bf16_t* __restrict__ Bt, int K, int n0,
                         char* smem, Epi epi) {
  const int tid = TIDX, lane = tid & 63, wave = tid >> 6, l15 = lane & 15, quad = lane >> 4;
  constexpr int M0 = 16384;
  f32x4 acc[8];
#pragma unroll
  for (int i = 0; i < 8; ++i) acc[i] = f32x4{0.f, 0.f, 0.f, 0.f};
  const int kq = K >> 2;
  const bf16_t* ag = A + (size_t)(M0 + l15) * lda + wave * kq + quad * 8;
  const int kb32 = K >> 5;
  const bf16_t* bg = Bt + ((size_t)(n0 >> 4) * kb32 + ((wave * kq) >> 5)) * 512 + lane * 8;
  bf16x8 a0, a1, b0[8], b1[8];
  auto tload = [&](bf16x8& a, bf16x8 (&b)[8], int k) {
    a = *(const bf16x8*)(ag + k);
#pragma unroll
    for (int nt = 0; nt < 8; ++nt) b[nt] = *(const bf16x8*)(bg + ((size_t)nt * kb32 + (k >> 5)) * 512);
  };
  tload(a0, b0, 0);
  tload(a1, b1, 32);
  for (int k = 0; k < kq; k += 64) {
#pragma unroll
    for (int nt = 0; nt < 8; ++nt) acc[nt] = MFMA16(b0[nt], a0, acc[nt]);
    if (k + 64 < kq) tload(a0, b0, k + 64);
#pragma unroll
    for (int nt = 0; nt < 8; ++nt) acc[nt] = MFMA16(b1[nt], a1, acc[nt]);
    if (k + 96 < kq) tload(a1, b1, k + 96);
  }
  f32x4* red = (f32x4*)smem;
#pragma unroll
  for (int nt = 0; nt < 8; ++nt) red[(wave * 8 + nt) * 64 + lane] = acc[nt];
  __syncthreads();
#pragma unroll
  for (int q = 0; q < 2; ++q) {
    const int nt = wave * 2 + q;
    f32x4 v = red[(0 * 8 + nt) * 64 + lane] + red[(1 * 8 + nt) * 64 + lane] + red[(2 * 8 + nt) * 64 + lane] +
              red[(3 * 8 + nt) * 64 + lane];
    epi(M0 + l15, n0 + nt * 16 + quad * 4, v);
  }
  __syncthreads();
}

template <class Epi>
DEVI void gemm_phase(const bf16_t* A, int lda, const bf16_t* Bt, int K, int nnt, char* smem, Epi epi,
                     int skip = 0) {
  const int nmain = 64 * nnt, ntiles = nmain + nnt;
  const int nb = gridDim.x - skip;
  const int b = BIDX - skip;
  const bool xmap = (skip == 0) && ((nnt & 7) == 0) && ((nb & 63) == 0);
  const int q = xmap ? (b & 7) * (nb >> 3) + (b >> 3) : b;
  for (int t0 = 0; t0 < ntiles; t0 += nb) {
    const int t = t0 + q;
    if (t >= ntiles) break;
    if (t < nmain) {
      int mt, nt;
      if (xmap) {
        const int s_ = t >> 6, w_ = t & 63, spr = nnt >> 3;
        const int sm = s_ / spr, sn = s_ - sm * spr;
        mt = sm * 8 + (w_ >> 3);
        nt = sn * 8 + (w_ & 7);
      } else {
        mt = t / nnt;
        nt = t - mt * nnt;
      }
      gemm_tile256b(A, lda, Bt, K, mt * 256, nt * 128, smem, epi);
    } else {
      gemm_tail_tile(A, lda, Bt, K, (t - nmain) * 128, smem, epi);
    }
  }
}

struct EpiEvenIn {
  bf16_t* r0;
  DEVI void operator()(int m, int n, f32x4 v) const {
    if (n < 1024) {
      if (m >= L) return;
      const bool isq = n < 512;
      const int nn = n & 511;
      const int h = nn >> 7, c = (nn >> 6) & 1, d = nn & 63;
      const float s = isq ? (0.125f * LOG2E) : 1.0f;
      bf16_t* dst = isq ? r0 + R0_Q + ((size_t)(h * 2 + c) * LR + m) * 64 + d
                        : r0 + R0_K + (size_t)(h * 2 + c) * LR * 64 + wfm(m, d, 64);
      *(u32x2*)dst = u32x2{pack2(v[0] * s, v[1] * s), pack2(v[2] * s, v[3] * s)};
    } else if (n < 1536) {
      const int nn = n - 1024;
      bf16_t* dst = r0 + R0_VT + (size_t)nn * LR + m;
      const bool ok = m < L;
#pragma unroll
      for (int i = 0; i < 4; ++i) {
        dst[(size_t)i * LR] = ok ? f2bf(v[i]) : (bf16_t)0;
        if (m >= 16384) {
          dst[(size_t)i * LR + 16] = 0;
          dst[(size_t)i * LR + 32] = 0;
          dst[(size_t)i * LR + 48] = 0;
        }
      }
    } else {
      if (m >= L) return;
      bf16_t* dst = r0 + R0_U + (size_t)m * 512 + (n - 1536);
      *(u32x2*)dst = u32x2{pack2(v[0], v[1]), pack2(v[2], v[3])};
    }
  }
};
struct EpiResid {
  Params p;
  DEVI void operator()(int m, int n, f32x4 v) const {
    if (m >= L) return;
    float* h = hfrow(p, m) + n;
    f32x4 o = *(f32x4*)h;
    o = o * ALPHA + v;
    *(f32x4*)h = o;
  }
};
struct EpiOddIn {
  bf16_t* raw;
  float* ba;
  DEVI void operator()(int m, int n, f32x4 v) const {
    if (m >= L) return;
    if (n < 3072) {
      *(u32x2*)(raw + (size_t)m * 3072 + n) = u32x2{pack2(v[0], v[1]), pack2(v[2], v[3])};
    } else if (n < 3088) {
      *(f32x4*)(ba + (size_t)m * 16 + (n - 3072)) = v;
    }
  }
};
struct EpiZ {
  bf16_t* z;
  DEVI void operator()(int m, int n, f32x4 v) const {
    if (m >= L) return;
    *(u32x2*)(z + (size_t)m * 1024 + n) = u32x2{pack2(v[0], v[1]), pack2(v[2], v[3])};
  }
};
struct EpiSqRelu {
  bf16_t* hid;
  DEVI void operator()(int m, int n, f32x4 v) const {
    if (m >= L) return;
    float a = fmaxf(v[0], 0.f), b = fmaxf(v[1], 0.f), c = fmaxf(v[2], 0.f), d = fmaxf(v[3], 0.f);
    *(u32x2*)(hid + (size_t)m * 4096 + n) = u32x2{pack2(a * a, b * b), pack2(c * c, d * d)};
  }
};

DEVI void tconv_seg(const float* src, int ld, int krows, int c0, int ncols, int ndst, bf16_t* dst, int dld,
                    char* smem) {
  float* tile = (float*)smem;
  const int tid = TIDX;
  const int nkt = krows >> 6, nnt = (ndst + 63) >> 6;
  const int lr = tid >> 4, lc = (tid & 15) * 4;
  const int kp = tid & 31, wn = tid >> 5;
  for (int t = BIDX; t < nkt * nnt; t += gridDim.x) {
    const int kt = t % nkt, nt = t / nkt;
    const int k0 = kt * 64, n0 = nt * 64;
#pragma unroll
    for (int i = 0; i < 4; ++i) {
      const int r = i * 16 + lr;
      f32x4 v = f32x4{0.f, 0.f, 0.f, 0.f};
      if (n0 + lc < ncols) v = *(const f32x4*)(src + (size_t)(k0 + r) * ld + c0 + n0 + lc);
      tile[r * 65 + lc + 0] = v[0];
      tile[r * 65 + lc + 1] = v[1];
      tile[r * 65 + lc + 2] = v[2];
      tile[r * 65 + lc + 3] = v[3];
    }
    __syncthreads();
#pragma unroll
    for (int i = 0; i < 8; ++i) {
      const int rn = i * 8 + wn;
      if (n0 + rn < ndst)
        *(unsigned*)(dst + wfm(n0 + rn, k0 + 2 * kp, dld)) = pack2(tile[(2 * kp) * 65 + rn], tile[(2 * kp + 1) * 65 + rn]);
    }
    __syncthreads();
  }
}

DEVI void convert_layer(const Params& p, int layer, char* smem) {
  bf16_t* wb = (bf16_t*)(p.ws + OFF_WB);
  const int j = layer >> 1;
  if ((layer & 1) == 0) {
    tconv_seg(p.in[3] + (size_t)j * 1024 * 2048, 2048, 1024, 0, 2048, 2048, wb + WB_IN, 1024, smem);
    tconv_seg(p.in[8] + (size_t)j * 1024 * 1024, 1024, 512, 0, 1024, 1024, wb + WB_OUT, 1024, smem);
    const float* pw = p.in[6] + (size_t)j * 4 * 128 * 128;
    const float* ps = p.in[7] + (size_t)j * 512;
    const float* wo = p.in[8] + (size_t)j * 1024 * 1024;
    {
      const int tid = TIDX;
      for (int item = BIDX; item < 512; item += gridDim.x) {
        const int g = item >> 7, c = item & 127;
        const float* pwr = pw + ((size_t)g * 128 + c) * 128;
        const float* wor = wo + (size_t)(512 + g * 128) * 1024 + tid * 4;
        f32x4 acc = f32x4{0.f, 0.f, 0.f, 0.f};
#pragma unroll 8
        for (int d = 0; d < 128; ++d) {
          const float a = pwr[d] * ps[g * 128 + d];
          const f32x4 w4 = *(const f32x4*)(wor + (size_t)d * 1024);
          acc = acc + w4 * a;
        }
#pragma unroll
        for (int e = 0; e < 4; ++e) wb[WB_OUT + wfm(tid * 4 + e, 512 + item, 1024)] = f2bf(acc[e]);
      }
    }
  } else {
    const float* wi = p.in[9] + (size_t)j * 1024 * 4112;
    tconv_seg(wi, 4112, 1024, 0, 3072, 3072, wb + WB_IN, 1024, smem);
    tconv_seg(wi, 4112, 1024, 4096, 16, 128, wb + WB_IN + (size_t)3072 * 1024, 1024, smem);
    tconv_seg(wi, 4112, 1024, 3072, 1024, 1024, wb + WB_Z, 1024, smem);
    tconv_seg(p.in[14] + (size_t)j * 1024 * 1024, 1024, 1024, 0, 1024, 1024, wb + WB_OUT, 1024, smem);
  }
  tconv_seg(p.in[15] + (size_t)layer * 1024 * 4096, 4096, 1024, 0, 4096, 4096, wb + WB_W1, 1024, smem);
  tconv_seg(p.in[16] + (size_t)layer * 4096 * 1024, 1024, 4096, 0, 1024, 1024, wb + WB_W2, 4096, smem);
}

DEVI void init_phase(const Params& p) {
  const int gt = BIDX * 256 + TIDX, nth = gridDim.x * 256;
  if (gt < 16) ((int*)(p.ws + OFF_MISC))[gt] = 0;
  bf16_t* hb = (bf16_t*)(p.ws + OFF_HB);
  for (int idx = gt; idx < L * 256; idx += nth) {
    const int t = idx >> 8, c = (idx & 255) * 4;
    f32x4 v = (t < 16) ? *(const f32x4*)(p.in[1] + t * 1024 + c) : *(const f32x4*)(p.in[0] + (size_t)(t - 16) * 1024 + c);
    *(f32x4*)(hfrow(p, t) + c) = v;
    *(u32x2*)(hb + (size_t)t * 1024 + c) = u32x2{pack2(v[0], v[1]), pack2(v[2], v[3])};
  }
}

DEVI void ln_phase(const Params& p, const float* g, const float* b) {
  const int tid = TIDX;
  const int lane = tid & 63;
  const int gw = BIDX * 4 + (tid >> 6), nw = gridDim.x * 4;
  bf16_t* hb = (bf16_t*)(p.ws + OFF_HB);
  for (int t0 = gw * 4; t0 < L; t0 += nw * 4) {
    f32x4 v[4][4];
    float* h[4];
#pragma unroll
    for (int r = 0; r < 4; ++r) {
      h[r] = hfrow(p, t0 + r);
#pragma unroll
      for (int i = 0; i < 4; ++i) v[r][i] = *(const f32x4*)(h[r] + i * 256 + lane * 4);
    }
    float s[4], q[4];
#pragma unroll
    for (int r = 0; r < 4; ++r) {
      s[r] = 0.f;
#pragma unroll
      for (int i = 0; i < 4; ++i) s[r] += v[r][i][0] + v[r][i][1] + v[r][i][2] + v[r][i][3];
    }
#pragma unroll
    for (int m = 32; m >= 1; m >>= 1) {
#pragma unroll
      for (int r = 0; r < 4; ++r) s[r] += __shfl_xor(s[r], m);
    }
#pragma unroll
    for (int r = 0; r < 4; ++r) {
      const float mu = s[r] * (1.f / 1024.f);
      q[r] = 0.f;
#pragma unroll
      for (int i = 0; i < 4; ++i) {
        v[r][i] = v[r][i] - mu;
        q[r] += v[r][i][0] * v[r][i][0] + v[r][i][1] * v[r][i][1] + v[r][i][2] * v[r][i][2] + v[r][i][3] * v[r][i][3];
      }
    }
#pragma unroll
    for (int m = 32; m >= 1; m >>= 1) {
#pragma unroll
      for (int r = 0; r < 4; ++r) q[r] += __shfl_xor(q[r], m);
    }
#pragma unroll
    for (int i = 0; i < 4; ++i) {
      const f32x4 gg = *(const f32x4*)(g + i * 256 + lane * 4);
      const f32x4 bb = *(const f32x4*)(b + i * 256 + lane * 4);
#pragma unroll
      for (int r = 0; r < 4; ++r) {
        const float rstd = rsqrtf(q[r] * (1.f / 1024.f) + 1e-5f);
        f32x4 y = v[r][i] * rstd * gg + bb;
        *(f32x4*)(h[r] + i * 256 + lane * 4) = y;
        *(u32x2*)(hb + (size_t)(t0 + r) * 1024 + i * 256 + lane * 4) = u32x2{pack2(y[0], y[1]), pack2(y[2], y[3])};
      }
    }
  }
}

constexpr int POOL_CHUNK = 2048, POOL_NCHUNK = (L * 64 + POOL_CHUNK - 1) / POOL_CHUNK;
DEVI void pool_chunk(const Params& p, int chunk) {
  const bf16_t* U = (const bf16_t*)(p.ws + OFF_R0) + R0_U;
  bf16_t* cat = (bf16_t*)(p.ws + OFF_R1);
  const int tid_ = TIDX;
  const int lim = min((chunk + 1) * POOL_CHUNK, L * 64);
  for (int idx = chunk * POOL_CHUNK + tid_; idx < lim; idx += 256) {
    const int t = idx >> 6, cc = idx & 63, g = cc >> 4;
    const int win = 2 << g;
    const int cnt = min(t + 1, win);
    float s[8];
#pragma unroll
    for (int e = 0; e < 8; ++e) s[e] = 0.f;
    u32x4 self = u32x4{0, 0, 0, 0};
    u32x4 tv[16];
#pragma unroll
    for (int k = 0; k < 16; ++k) {
      tv[k] = u32x4{0, 0, 0, 0};
      if (k < cnt) tv[k] = *(const u32x4*)(U + (size_t)(t - k) * 512 + cc * 8);
    }
    self = tv[0];
#pragma unroll
    for (int k = 0; k < 16; ++k) {
#pragma unroll
      for (int e = 0; e < 4; ++e) {
        s[2 * e] += bflo(tv[k][e]);
        s[2 * e + 1] += bfhi(tv[k][e]);
      }
    }
    const float inv = 1.f / (float)cnt;
    u32x4 o;
#pragma unroll
    for (int e = 0; e < 4; ++e) o[e] = pack2(s[2 * e] * inv - bflo(self[e]), s[2 * e + 1] * inv - bfhi(self[e]));
    *(u32x4*)(cat + (size_t)t * 1024 + 512 + cc * 8) = o;
  }
}

DEVI void attn_item(const Params& p, int j, int h, int qt, float lam, float one_m_linit, char* smem) {
  const int tid = TIDX, lane = tid & 63, wave = tid >> 6;
  const int rg = wave & 1, c = wave >> 1, l15 = lane & 15, quad = lane >> 4;
  const bf16_t* r0 = (const bf16_t*)(p.ws + OFF_R0);
  const bf16_t* Qg = r0 + R0_Q + (size_t)(h * 2 + c) * LR * 64;
  const bf16_t* Kfm = r0 + R0_K + (size_t)(h * 2 + c) * LR * 64 + lane * 8;
  const bf16_t* Vg = r0 + R0_VT + (size_t)(h * 128) * LR;
  const float* tbl = (const float*)(smem + 73728);
  const int q0 = qt * 64;
  const int qw = q0 + rg * 32;
  bf16x8 qf[2][2];
#pragma unroll
  for (int qi = 0; qi < 2; ++qi)
#pragma unroll
    for (int ks = 0; ks < 2; ++ks)
      qf[qi][ks] = *(const bf16x8*)(Qg + (size_t)(qw + qi * 16 + l15) * 64 + ks * 32 + quad * 8);
  f32x4 oacc[2][8];
#pragma unroll
  for (int qi = 0; qi < 2; ++qi)
#pragma unroll
    for (int d = 0; d < 8; ++d) oacc[qi][d] = f32x4{0.f, 0.f, 0.f, 0.f};
  float mrun[2] = {0.f, 0.f};
  f32x4 lacc[2] = {f32x4{0.f, 0.f, 0.f, 0.f}, f32x4{0.f, 0.f, 0.f, 0.f}};
  const bf16x8 ones = {16256, 16256, 16256, 16256, 16256, 16256, 16256, 16256};
  const int nkt = qt + 1;
  const int krow = tid >> 3, kkc = tid & 7;
  u32x4 rv[4];
  auto gload = [&](int kt) {
    const int k0 = kt * 64;
#pragma unroll
    for (int i = 0; i < 4; ++i) rv[i] = *(const u32x4*)(Vg + (size_t)(krow + i * 32) * LR + k0 + kkc * 8);
  };
  auto lstore = [&](int buf) {
    char* b = smem + buf * 34816;
#pragma unroll
    for (int i = 0; i < 4; ++i) *(u32x4*)(b + 16384 + (krow + i * 32) * 144 + kkc * 16) = rv[i];
  };
  bf16x8 kf[4][2];
  auto kload = [&](int kt) {
#pragma unroll
    for (int ki = 0; ki < 4; ++ki)
#pragma unroll
      for (int ks = 0; ks < 2; ++ks) kf[ki][ks] = *(const bf16x8*)(Kfm + ((size_t)((kt * 4 + ki) * 2 + ks)) * 512);
  };
  gload(0);
  kload(0);
  lstore(0);
  __syncthreads();
  for (int kt = 0; kt < nkt; ++kt) {
    const char* b = smem + (kt & 1) * 34816;
    if (kt + 1 < nkt) gload(kt + 1);
    const int k0 = kt * 64;
    if (k0 <= qw + 31) {
      f32x4 st[2][4];
#pragma unroll
      for (int qi = 0; qi < 2; ++qi)
#pragma unroll
        for (int ki = 0; ki < 4; ++ki) st[qi][ki] = f32x4{-mrun[qi], -mrun[qi], -mrun[qi], -mrun[qi]};
      const char* vb = b + 16384;
      bf16x8 vf[2][4];
      auto vload = [&](int g, int slot) {
#pragma unroll
        for (int dd = 0; dd < 2; ++dd)
#pragma unroll
          for (int s2 = 0; s2 < 2; ++s2) {
            const char* a = vb + ((g * 2 + dd) * 16 + l15) * 144 + s2 * 64 + quad * 8;
            vf[slot][dd * 2 + s2] = mk8(*(const u32x2*)a, *(const u32x2*)(a + 32));
          }
      };
      __builtin_amdgcn_s_setprio(2);
#pragma unroll
      for (int ki = 0; ki < 4; ++ki)
#pragma unroll
        for (int ks = 0; ks < 2; ++ks) {
#pragma unroll
          for (int qi = 0; qi < 2; ++qi) st[qi][ki] = MFMA16(kf[ki][ks], qf[qi][ks], st[qi][ki]);
        }
      __builtin_amdgcn_s_setprio(0);
      if (kt + 1 < nkt) kload(kt + 1);
      vload(0, 0);
      __builtin_amdgcn_sched_barrier(0);
      const bool far = (qw - (k0 + 63)) >= 128;
      const bool first = (kt == 0);
#pragma unroll
      for (int qi = 0; qi < 2; ++qi) {
        if (!far) {
          const int qpos = qw + qi * 16 + l15;
#pragma unroll
          for (int ki = 0; ki < 4; ++ki)
#pragma unroll
            for (int jj = 0; jj < 4; ++jj) {
              const int n = qpos - (k0 + ki * 16 + quad * 4 + jj);
              st[qi][ki][jj] = (n >= 0) ? st[qi][ki][jj] + tbl[min(n, 128)] : -1e30f;
            }
        }
        float tmax = st[qi][0][0];
#pragma unroll
        for (int ki = 0; ki < 4; ++ki)
#pragma unroll
          for (int jj = 0; jj < 4; jj += 2) tmax = fmaxf(fmaxf(tmax, st[qi][ki][jj]), st[qi][ki][jj + 1]);
        tmax = fmaxf(tmax, __shfl_xor(tmax, 16));
        tmax = fmaxf(tmax, __shfl_xor(tmax, 32));
        if (first || __any(tmax > 8.0f)) {
          const float dm = first ? tmax : fmaxf(tmax, 0.f);
          const float alpha = __builtin_amdgcn_exp2f(-dm);
          mrun[qi] += dm;
          lacc[qi] = lacc[qi] * alpha;
#pragma unroll
          for (int d = 0; d < 8; ++d) oacc[qi][d] = oacc[qi][d] * alpha;
#pragma unroll
          for (int ki = 0; ki < 4; ++ki) st[qi][ki] = st[qi][ki] - dm;
        }
#pragma unroll
        for (int ki = 0; ki < 4; ++ki)
#pragma unroll
          for (int jj = 0; jj < 4; ++jj) st[qi][ki][jj] = __builtin_amdgcn_exp2f(st[qi][ki][jj]);
      }
      bf16x8 pb[2][2];
#pragma unroll
      for (int qi = 0; qi < 2; ++qi)
#pragma unroll
        for (int s2 = 0; s2 < 2; ++s2) pb[qi][s2] = pack8(st[qi][2 * s2], st[qi][2 * s2 + 1]);
      __builtin_amdgcn_s_setprio(2);
#pragma unroll
      for (int qi = 0; qi < 2; ++qi)
#pragma unroll
        for (int s2 = 0; s2 < 2; ++s2) lacc[qi] = MFMA16(ones, pb[qi][s2], lacc[qi]);
#pragma unroll
      for (int g = 0; g < 4; ++g) {
        if (g < 3) vload(g + 1, (g + 1) & 1);
#pragma unroll
        for (int dd = 0; dd < 2; ++dd)
#pragma unroll
          for (int s2 = 0; s2 < 2; ++s2)
#pragma unroll
            for (int qi = 0; qi < 2; ++qi)
              oacc[qi][g * 2 + dd] = MFMA16(vf[g & 1][dd * 2 + s2], pb[qi][s2], oacc[qi][g * 2 + dd]);
        __builtin_amdgcn_sched_barrier(0);
      }
      __builtin_amdgcn_s_setprio(0);
    }
    if (kt + 1 < nkt) lstore((kt + 1) & 1);
    __syncthreads();
  }
#pragma unroll
  for (int qi = 0; qi < 2; ++qi) {
    const float inv = 1.f / lacc[qi][0];
#pragma unroll
    for (int d = 0; d < 8; ++d) oacc[qi][d] = oacc[qi][d] * inv;
  }
  f32x4* xb = (f32x4*)smem;
  if (c == 1) {
#pragma unroll
    for (int qi = 0; qi < 2; ++qi)
#pragma unroll
      for (int d = 0; d < 8; ++d) xb[((rg * 2 + qi) * 8 + d) * 64 + lane] = oacc[qi][d];
  }
  __syncthreads();
  if (c == 0) {
    const float* sw = p.in[5] + j * 128;
    bf16_t* cat = (bf16_t*)(p.ws + OFF_R1);
#pragma unroll
    for (int qi = 0; qi < 2; ++qi) {
      float ss = 0.f;
#pragma unroll
      for (int d = 0; d < 8; ++d) {
        f32x4 o1 = xb[((rg * 2 + qi) * 8 + d) * 64 + lane];
        f32x4 o = oacc[qi][d] - o1 * lam;
        oacc[qi][d] = o;
        ss += o[0] * o[0] + o[1] * o[1] + o[2] * o[2] + o[3] * o[3];
      }
      ss += __shfl_xor(ss, 16);
      ss += __shfl_xor(ss, 32);
      const float r = rsqrtf(ss * (1.f / 128.f) + 1e-6f) * one_m_linit;
      const int qpos = qw + qi * 16 + l15;
      if (qpos < L) {
#pragma unroll
        for (int d = 0; d < 8; ++d) {
          const int dv = d * 16 + quad * 4;
          f32x4 w = *(const f32x4*)(sw + dv);
          f32x4 o = oacc[qi][d] * r * w;
          *(u32x2*)(cat + (size_t)qpos * 1024 + h * 128 + dv) = u32x2{pack2(o[0], o[1]), pack2(o[2], o[3])};
        }
      }
    }
  }
  __syncthreads();
}

DEVI void attn_phase(const Params& p, int j, float lambda_init, char* smem, int* s_item) {
  const int tid = TIDX;
  const float* lv = p.in[4] + j * 256;
  float d01 = 0.f, d23 = 0.f;
  for (int i = 0; i < 64; ++i) {
    d01 += lv[i] * lv[64 + i];
    d23 += lv[128 + i] * lv[192 + i];
  }
  const float lam = expf(d01) - expf(d23) + lambda_init;
  int* counter = (int*)(p.ws + OFF_MISC) + j;
  float* tbl = (float*)(smem + 73728);
  int cur_h = -1;
  for (;;) {
    if (tid == 0) *s_item = atomicAdd(counter, 1);
    __syncthreads();
    const int item = *s_item;
    __syncthreads();
    if (item >= 4 * 257) break;
    const int h = item & 3, qt = 256 - (item >> 2);
    if (h != cur_h) {
      if (tid < 129) {
        int bucket;
        if (tid < 16) bucket = tid;
        else {
          bucket = 16 + (int)(logf((float)tid / 16.0f) / 2.0794415416798357f * 16.0f);
          bucket = min(bucket, 31);
        }
        tbl[tid] = (p.in[2][bucket * 4 + h] - p.in[2][31 * 4 + h]) * LOG2E;
      }
      cur_h = h;
      __syncthreads();
    }
    attn_item(p, j, h, qt, lam, 1.0f - lambda_init, smem);
  }
  int* pctr = (int*)(p.ws + OFF_MISC) + 8 + j;
  for (;;) {
    if (tid == 0) *s_item = atomicAdd(pctr, 1);
    __syncthreads();
    const int c = *s_item;
    __syncthreads();
    if (c >= POOL_NCHUNK) break;
    pool_chunk(p, c);
  }
}

DEVI void conv_phase(const Params& p, int j) {
  const bf16_t* raw = (const bf16_t*)(p.ws + OFF_R0);
  bf16_t* r1 = (bf16_t*)(p.ws + OFF_R1);
  const float* cw = p.in[10] + (size_t)j * 3072 * 4;
  const int tid = TIDX;
  const int lane = tid & 63;
  const int gw = BIDX * 4 + (tid >> 6), nw = gridDim.x * 4;
  for (int item = gw; item < 1025 * 24; item += nw) {
    const int run = item / 24, seg = item - run * 24;
    const int tb = run * 16;
    const int ch = seg * 128 + lane * 2;
    const f32x4 w0 = *(const f32x4*)(cw + (size_t)ch * 4);
    const f32x4 w1 = *(const f32x4*)(cw + (size_t)ch * 4 + 4);
    unsigned xv[19];
#pragma unroll
    for (int r = 0; r < 19; ++r) {
      const int tt = tb - 3 + r;
      xv[r] = 0;
      if (tt >= 0) xv[r] = *(const unsigned*)(raw + (size_t)tt * 3072 + ch);
    }
    float y0[16], y1[16], ss[16];
#pragma unroll
    for (int i = 0; i < 16; ++i) {
      float a0 = 0.f, a1 = 0.f;
#pragma unroll
      for (int k = 0; k < 4; ++k) {
        a0 += w0[k] * bflo(xv[i + k]);
        a1 += w1[k] * bfhi(xv[i + k]);
      }
      a0 = a0 / (1.f + __expf(-a0));
      a1 = a1 / (1.f + __expf(-a1));
      y0[i] = a0;
      y1[i] = a1;
      ss[i] = a0 * a0 + a1 * a1;
    }
    if (seg < 16) {
#pragma unroll
      for (int m = 32; m >= 1; m >>= 1) {
#pragma unroll
        for (int i = 0; i < 16; ++i) ss[i] += __shfl_xor(ss[i], m);
      }
      const float sc = (seg < 8) ? 0.08838834764831845f : 1.0f;
#pragma unroll
      for (int i = 0; i < 16; ++i) {
        const float r = rsqrtf(ss[i] + 1e-6f) * sc;
        y0[i] *= r;
        y1[i] *= r;
      }
    }
    int chw = ch;
    if (seg < 8) {
      const int cc = lane * 2;
      chw = seg * 128 + (cc & 96) + (((cc >> 2) & 3) << 3) + (((cc >> 4) & 1) << 2) + (cc & 3);
    }
#pragma unroll
    for (int i = 0; i < 16; ++i) *(unsigned*)(r1 + (size_t)(tb + i) * 3072 + chw) = pack2(y0[i], y1[i]);
  }
}

DEVI void prep_item(const Params& p, int j, int n, int h, char* smem) {
  const int tid = TIDX, lane = tid & 63, wave = tid >> 6, l15 = lane & 15, quad = lane >> 4;
  bf16_t* r1 = (bf16_t*)(p.ws + OFF_R1);
  bf16_t* r0 = (bf16_t*)(p.ws + OFF_R0);
  const float* ba = (const float*)(p.ws + OFF_BA);
  char* qs = smem;
  char* ks = smem + 17408;
  char* vs = smem + 34816;
  float* am = (float*)(smem + 52224);
  float* sbeta = (float*)(smem + 69632);
  float* sgc = sbeta + 64;
  const int t0 = n * 64 - 48;
#pragma unroll
  for (int i = 0; i < 4; ++i) {
    const int ch = tid + i * 256, row = ch >> 4, kc = ch & 15;
    const int t = t0 + row;
    u32x4 vq = u32x4{0, 0, 0, 0}, vk = vq, vv = vq;
    if (t >= 0) {
      const bf16_t* src = r1 + (size_t)t * 3072 + h * 128 + kc * 8;
      vq = *(const u32x4*)src;
      vk = *(const u32x4*)(src + 1024);
      vv = *(const u32x4*)(src + 2048);
    }
    {
      const int s_ = kc >> 2, q_ = kc & 3;
      *(u32x2*)(qs + row * 272 + (s_ * 32 + q_ * 4) * 2) = u32x2{vq.x, vq.y};
      *(u32x2*)(qs + row * 272 + (s_ * 32 + 16 + q_ * 4) * 2) = u32x2{vq.z, vq.w};
    }
    *(u32x4*)(ks + row * 272 + kc * 16) = vk;
    *(u32x4*)(vs + row * 272 + kc * 16) = vv;
  }
  if (wave == 0) {
    const int t = t0 + lane;
    float beta = 0.f, g = 0.f;
    if (t >= 0) {
      const float braw = ba[(size_t)t * 16 + h], araw = ba[(size_t)t * 16 + 8 + h];
      beta = 1.f / (1.f + expf(-braw));
      const float x = araw + p.in[12][j * 8 + h];
      const float sp = (x > 20.f) ? x : log1pf(expf(x));
      g = -expf(p.in[11][j * 8 + h]) * sp;
    }
#pragma unroll
    for (int off = 1; off < 64; off <<= 1) {
      const float o = __shfl_up(g, off);
      if (lane >= off) g += o;
    }
    sbeta[lane] = beta;
    sgc[lane] = g;
    {
      const float glast = __shfl(g, 63);
      float* gout = (float*)(r0 + R0_G) + (size_t)(n * 8 + h) * 192;
      gout[lane] = __expf(g);
      gout[64 + lane] = __expf(glast - g);
      if (lane == 0) gout[128] = __expf(glast);
    }
  }
  __syncthreads();
  {
    f32x4 akk[4], aqk[4];
#pragma unroll
    for (int nt = 0; nt < 4; ++nt) akk[nt] = aqk[nt] = f32x4{0.f, 0.f, 0.f, 0.f};
#pragma unroll
    for (int s = 0; s < 4; ++s) {
      bf16x8 ka = *(const bf16x8*)(ks + (wave * 16 + l15) * 272 + s * 64 + quad * 16);
      bf16x8 qa = *(const bf16x8*)(qs + (wave * 16 + l15) * 272 + s * 64 + quad * 16);
#pragma unroll
      for (int nt = 0; nt < 4; ++nt) {
        bf16x8 kb = *(const bf16x8*)(ks + (nt * 16 + l15) * 272 + s * 64 + quad * 16);
        akk[nt] = MFMA16(ka, kb, akk[nt]);
        aqk[nt] = MFMA16(qa, kb, aqk[nt]);
      }
    }
    bf16_t* qkout = r0 + R0_QK + (size_t)(n * 8 + h) * 4096;
#pragma unroll
    for (int nt = 0; nt < 4; ++nt) {
      const int jx = nt * 16 + l15;
      const float gj = sgc[jx];
#pragma unroll
      for (int jj = 0; jj < 4; ++jj) {
        const int i = wave * 16 + quad * 4 + jj;
        const float dec = __expf(fminf(sgc[i] - gj, 0.f));
        am[i * 68 + jx] = (jx < i) ? sbeta[i] * akk[nt][jj] * dec : 0.f;
        qkout[i * 64 + jx] = f2bf((jx <= i) ? aqk[nt][jj] * dec : 0.f);
      }
    }
  }
  __syncthreads();
  {
    bf16_t* kt = r0 + R0_KT + (size_t)(n * 8 + h) * 8192;
#pragma unroll
    for (int i = 0; i < 4; ++i) {
      const int unit = tid + i * 256, d = unit >> 3, i0 = (unit & 7) * 8;
      unsigned e[8];
#pragma unroll
      for (int q = 0; q < 8; ++q) e[q] = *(const unsigned short*)(ks + (i0 + q) * 272 + d * 2);
      u32x4 o = {e[0] | (e[1] << 16), e[2] | (e[3] << 16), e[4] | (e[5] << 16), e[6] | (e[7] << 16)};
      *(u32x4*)(kt + d * 64 + i0) = o;
    }
  }
  {
    const int c = tid;
    const bool isu = c < 128;
    const char* src = isu ? (vs + c * 2) : (ks + (c - 128) * 2);
    float x[64];
#pragma unroll
    for (int i = 0; i < 64; ++i) x[i] = 0.f;
    int zero;
    asm volatile("v_mov_b32 %0, 0" : "=v"(zero));
#pragma unroll
    for (int i = 0; i < 64; ++i) {
      const float* amz = am + zero;
      const float* sbz = sbeta + zero;
      const float eg = __expf(sbz[64 + i]);
      float acc = bf2f(*(const unsigned short*)(src + i * 272)) * sbz[i] * (isu ? 1.0f : eg);
#pragma unroll
      for (int j4 = 0; j4 < (i + 3) / 4; ++j4) {
        const f32x4 a = *(const f32x4*)(amz + i * 68 + j4 * 4);
        acc -= a[0] * x[j4 * 4 + 0];
        acc -= a[1] * x[j4 * 4 + 1];
        acc -= a[2] * x[j4 * 4 + 2];
        acc -= a[3] * x[j4 * 4 + 3];
      }
      asm volatile("" : "+v"(zero), "+v"(acc));
      x[i] = acc;
    }
    bf16_t* dst = r1 + (isu ? 2048 : 1024) + h * 128 + (c & 127);
#pragma unroll
    for (int i = 0; i < 64; ++i) {
      const int t = t0 + i;
      if (t >= 0) dst[(size_t)t * 3072] = f2bf(x[i]);
    }
  }
  __syncthreads();
}

constexpr int NW = 2;
DEVI void scan_item(const Params& p, int h, int sl, char* smem) {
  const int tid = TIDX, lane = tid & 63, wave = tid >> 6, l15 = lane & 15, quad = lane >> 4;
  bf16_t* r1 = (bf16_t*)(p.ws + OFF_R1);
  const bf16_t* r0 = (const bf16_t*)(p.ws + OFF_R0);
  char* wsm = smem;
  char* qksm = smem + 17408;
  char* ktsm = smem + 26624;
  char* usm = smem + 45056;
  float* gsm = (float*)(smem + 50176);
  char* sbx = smem + 51200;
  char* vbx = smem + 59392;
  constexpr int USTR = (NW * 16 + 8) * 2;
  const int vb0 = sl * NW * 16;
  const bool is_state = wave < NW;
  const int cw = is_state ? wave : wave - NW;
  u32x4 pw[4], pqk[2], pkt[4], pg = u32x4{0, 0, 0, 0}, pu = u32x4{0, 0, 0, 0};
  auto gload = [&](int n) {
    const int t0 = n * 64 - 48;
#pragma unroll
    for (int i = 0; i < 4; ++i) {
      const int ch = tid + i * 256, row = ch >> 4, kc = ch & 15;
      const int t = t0 + row;
      pw[i] = u32x4{0, 0, 0, 0};
      if (t >= 0) pw[i] = *(const u32x4*)(r1 + (size_t)t * 3072 + 1024 + h * 128 + kc * 8);
    }
    const bf16_t* qk = r0 + R0_QK + (size_t)(n * 8 + h) * 4096;
#pragma unroll
    for (int i = 0; i < 2; ++i) pqk[i] = *(const u32x4*)(qk + (size_t)(tid + i * 256) * 8);
    const bf16_t* kt = r0 + R0_KT + (size_t)(n * 8 + h) * 8192;
#pragma unroll
    for (int i = 0; i < 4; ++i) pkt[i] = *(const u32x4*)(kt + (size_t)(tid + i * 256) * 8);
    if (tid < 48) pg = *(const u32x4*)((const float*)(r0 + R0_G) + (size_t)(n * 8 + h) * 192 + tid * 4);
    if (tid < 64 * NW * 2) {
      const int row = tid / (NW * 2), kc = tid % (NW * 2);
      const int t = t0 + row;
      pu = u32x4{0, 0, 0, 0};
      if (t >= 0) pu = *(const u32x4*)(r1 + (size_t)t * 3072 + 2048 + h * 128 + vb0 + kc * 8);
    }
  };
  auto lstore = [&]() {
#pragma unroll
    for (int i = 0; i < 4; ++i) {
      const int ch = tid + i * 256, row = ch >> 4, kc = ch & 15;
      *(u32x4*)(wsm + row * 272 + kc * 16) = pw[i];
    }
    if (tid < 48) *(u32x4*)(gsm + tid * 4) = pg;
    if (tid < 64 * NW * 2) {
      const int row = tid / (NW * 2), kc = tid % (NW * 2);
      *(u32x4*)(usm + row * USTR + kc * 16) = pu;
    }
  };
  auto lstore2 = [&]() {
#pragma unroll
    for (int i = 0; i < 2; ++i) {
      const int ch = tid + i * 256, row = ch >> 3, kc = ch & 7;
      *(u32x4*)(qksm + row * 144 + kc * 16) = pqk[i];
    }
#pragma unroll
    for (int i = 0; i < 4; ++i) {
      const int ch = tid + i * 256, row = ch >> 3, kc = ch & 7;
      *(u32x4*)(ktsm + row * 144 + kc * 16) = pkt[i];
    }
  };
  bf16x8 qfr[2][4];
  auto qload = [&](int n) {
    const int t0 = n * 64 - 48;
#pragma unroll
    for (int mt = 0; mt < 2; ++mt) {
      const int t = t0 + (cw * 2 + mt) * 16 + l15;
#pragma unroll
      for (int s = 0; s < 4; ++s) {
        u32x4 v4 = u32x4{0, 0, 0, 0};
        if (t >= 0) v4 = *(const u32x4*)(r1 + (size_t)t * 3072 + h * 128 + s * 32 + quad * 8);
        qfr[mt][s] = __builtin_bit_cast(bf16x8, v4);
      }
    }
  };
  f32x4 S[8];
#pragma unroll
  for (int r = 0; r < 8; ++r) S[r] = f32x4{0.f, 0.f, 0.f, 0.f};
  gload(0);
  if (!is_state) qload(0);
  for (int n = 0; n < NCH; ++n) {
    lstore();
    if (is_state) {
#pragma unroll
      for (int s = 0; s < 4; ++s) *(bf16x8*)(sbx + ((cw * 4 + s) * 64 + lane) * 16) = pack8(S[2 * s], S[2 * s + 1]);
    }
    __syncthreads();
    lstore2();
    if (n + 1 < NCH) gload(n + 1);
    if (is_state) {
      bf16x8 sb[4];
#pragma unroll
      for (int s = 0; s < 4; ++s) sb[s] = pack8(S[2 * s], S[2 * s + 1]);
      f32x4 vnew[4];
#pragma unroll
      for (int mt = 0; mt < 4; ++mt) vnew[mt] = f32x4{0.f, 0.f, 0.f, 0.f};
#pragma unroll
      for (int s = 0; s < 4; ++s) {
#pragma unroll
        for (int mt = 0; mt < 4; ++mt) {
          const char* aw = wsm + (mt * 16 + l15) * 272 + s * 64 + quad * 8;
          bf16x8 wf = mk8(*(const u32x2*)aw, *(const u32x2*)(aw + 32));
          vnew[mt] = MFMA16(wf, sb[s], vnew[mt]);
        }
      }
#pragma unroll
      for (int mt = 0; mt < 4; ++mt) {
#pragma unroll
        for (int jj = 0; jj < 4; ++jj) {
          const int cidx = mt * 16 + quad * 4 + jj;
          const float u = bf2f(*(const unsigned short*)(usm + cidx * USTR + (cw * 16 + l15) * 2));
          vnew[mt][jj] = u - vnew[mt][jj];
        }
      }
#pragma unroll
      for (int s2 = 0; s2 < 2; ++s2)
        *(bf16x8*)(vbx + ((cw * 2 + s2) * 64 + lane) * 16) = pack8(vnew[2 * s2], vnew[2 * s2 + 1]);
      __syncthreads();
      const float eglast = gsm[128];
      bf16x8 vb[2];
#pragma unroll
      for (int mt = 0; mt < 4; ++mt) {
        const f32x4 gd4 = *(const f32x4*)(gsm + 64 + mt * 16 + quad * 4);
        vnew[mt] = vnew[mt] * gd4;
      }
#pragma unroll
      for (int s2 = 0; s2 < 2; ++s2) vb[s2] = pack8(vnew[2 * s2], vnew[2 * s2 + 1]);
#pragma unroll
      for (int r = 0; r < 8; ++r) S[r] = S[r] * eglast;
#pragma unroll
      for (int s2 = 0; s2 < 2; ++s2) {
#pragma unroll
        for (int r = 0; r < 8; ++r) {
          const char* ap = ktsm + (r * 16 + l15) * 144 + s2 * 64 + quad * 8;
          bf16x8 f = mk8(*(const u32x2*)ap, *(const u32x2*)(ap + 32));
          S[r] = MFMA16(f, vb[s2], S[r]);
        }
      }
    } else {
      f32x4 acco[2][NW];
#pragma unroll
      for (int ct = 0; ct < NW; ++ct) {
        bf16x8 sb[4];
#pragma unroll
        for (int s = 0; s < 4; ++s) sb[s] = *(const bf16x8*)(sbx + ((ct * 4 + s) * 64 + lane) * 16);
#pragma unroll
        for (int m = 0; m < 2; ++m) acco[m][ct] = f32x4{0.f, 0.f, 0.f, 0.f};
#pragma unroll
        for (int s = 0; s < 4; ++s)
#pragma unroll
          for (int m = 0; m < 2; ++m) acco[m][ct] = MFMA16(qfr[m][s], sb[s], acco[m][ct]);
      }
      if (n + 1 < NCH) qload(n + 1);
      __syncthreads();
      const int t0 = n * 64 - 48;
#pragma unroll
      for (int m = 0; m < 2; ++m) {
        const int mt = cw * 2 + m;
        bf16x8 qkf[2];
#pragma unroll
        for (int s2 = 0; s2 < 2; ++s2) {
          const char* a = qksm + (mt * 16 + l15) * 144 + s2 * 64 + quad * 8;
          qkf[s2] = mk8(*(const u32x2*)a, *(const u32x2*)(a + 32));
        }
        const f32x4 ge4 = *(const f32x4*)(gsm + mt * 16 + quad * 4);
#pragma unroll
        for (int ct = 0; ct < NW; ++ct) {
          f32x4 a2 = f32x4{0.f, 0.f, 0.f, 0.f};
#pragma unroll
          for (int s2 = 0; s2 < 2; ++s2) {
            const bf16x8 vb = *(const bf16x8*)(vbx + ((ct * 2 + s2) * 64 + lane) * 16);
            a2 = MFMA16(qkf[s2], vb, a2);
          }
#pragma unroll
          for (int jj = 0; jj < 4; ++jj) {
            const int t = t0 + mt * 16 + quad * 4 + jj;
            const float o = ge4[jj] * acco[m][ct][jj] + a2[jj];
            if (t >= 0) r1[(size_t)t * 3072 + 2048 + h * 128 + vb0 + ct * 16 + l15] = f2bf(o);
          }
        }
      }
    }
    __syncthreads();
  }
}

DEVI void gate_phase(const Params& p, int j) {
  bf16_t* r1 = (bf16_t*)(p.ws + OFF_R1);
  const bf16_t* z = (const bf16_t*)(p.ws + OFF_R0) + R0_Z;
  const float* nw = p.in[13] + j * 128;
  const int tid = TIDX;
  const int lane = tid & 63;
  const int gw = BIDX * 4 + (tid >> 6), nwv = gridDim.x * 4;
  const int half = lane >> 5, l31 = lane & 31;
  const f32x4 w = *(const f32x4*)(nw + l31 * 4);
  for (int t = gw; t < L; t += nwv) {
    u32x2 ov[4], zv[4];
#pragma unroll
    for (int q = 0; q < 4; ++q) {
      const int h = q * 2 + half;
      ov[q] = *(const u32x2*)(r1 + (size_t)t * 3072 + 2048 + h * 128 + l31 * 4);
      zv[q] = *(const u32x2*)(z + (size_t)t * 1024 + h * 128 + l31 * 4);
    }
    float ss[4];
#pragma unroll
    for (int q = 0; q < 4; ++q) {
      const float o0 = bflo(ov[q].x), o1 = bfhi(ov[q].x), o2 = bflo(ov[q].y), o3 = bfhi(ov[q].y);
      ss[q] = o0 * o0 + o1 * o1 + o2 * o2 + o3 * o3;
    }
#pragma unroll
    for (int m = 16; m >= 1; m >>= 1) {
#pragma unroll
      for (int q = 0; q < 4; ++q) ss[q] += __shfl_xor(ss[q], m);
    }
#pragma unroll
    for (int q = 0; q < 4; ++q) {
      const int h = q * 2 + half;
      const float r = rsqrtf(ss[q] * (1.f / 128.f) + 1e-6f);
      const float o[4] = {bflo(ov[q].x), bfhi(ov[q].x), bflo(ov[q].y), bfhi(ov[q].y)};
      const float zz[4] = {bflo(zv[q].x), bfhi(zv[q].x), bflo(zv[q].y), bfhi(zv[q].y)};
      float y[4];
#pragma unroll
      for (int e = 0; e < 4; ++e) y[e] = o[e] * r * w[e] * (zz[e] / (1.f + __expf(-zz[e])));
      *(u32x2*)(r1 + (size_t)t * 3072 + h * 128 + l31 * 4) = u32x2{pack2(y[0], y[1]), pack2(y[2], y[3])};
    }
  }
}


#define XB_TMO      128
#define XB_XCNT(j)  (256  + 64 * (j))
#define XB_XSUB(j)  (1280 + 64 * (j))
#define XB_XGEN(j)  (2304 + 64 * (j))
#define XB_TOP      3328
#define XB_TOPGEN   3392
#define XCD_BAR_WORDS 3456
#define XB_SPIN_CAP (1u << 20)
#define LAS __attribute__((address_space(3)))
DEVI unsigned xb_ld(unsigned* p) { return __hip_atomic_load(p, __ATOMIC_RELAXED, __HIP_MEMORY_SCOPE_AGENT); }
DEVI unsigned xb_add(unsigned* p, unsigned v) { return __hip_atomic_fetch_add(p, v, __ATOMIC_RELAXED, __HIP_MEMORY_SCOPE_AGENT); }
DEVI unsigned xb_xcc_id() { return (unsigned)__builtin_amdgcn_s_getreg((3 << 11) | 20) & 0xFu; }
#define XB_SPIN(cond, bar) do { unsigned _sp = 0; while (cond) { __builtin_amdgcn_s_sleep(24); \
    if ((++_sp & 255u) == 0u) { if (xb_ld(&(bar)[XB_TMO])) break; if (_sp > XB_SPIN_CAP) { atomicAdd(&(bar)[XB_TMO], 1u); break; } } } } while (0)
struct XcdBarrier {
  unsigned* bar; unsigned x;
  volatile LAS unsigned* st;
};
DEVI XcdBarrier xcd_barrier_post(unsigned* bar, volatile LAS unsigned* st) {
  XcdBarrier b; b.bar = bar; b.x = xb_xcc_id(); b.st = st;
  if (threadIdx.x == 0) (void)xb_add(&bar[XB_XCNT(b.x)], 1u);
  return b;
}
DEVI void xcd_barrier_complete(unsigned* bar, unsigned x, unsigned& nloc, unsigned& nx) {
  const unsigned G = gridDim.x * gridDim.y * gridDim.z;
  unsigned sum, cnt, mine, sp = 0u;
  for (;;) {
    sum = 0u; cnt = 0u; mine = 0u;
#pragma unroll
    for (unsigned j = 0; j < 16; ++j) { const unsigned c = xb_ld(&bar[XB_XCNT(j)]); sum += c; cnt += (c > 0u) ? 1u : 0u; mine = (j == x) ? c : mine; }
    if (sum == G) break;
    __builtin_amdgcn_s_sleep(1);
    if ((++sp & 255u) == 0u) { if (xb_ld(&bar[XB_TMO])) break; if (sp > XB_SPIN_CAP) { atomicAdd(&bar[XB_TMO], 1u); break; } }
  }
  nloc = mine > 0u ? mine : 1u; nx = cnt > 0u ? cnt : 1u;
}
DEVI void xcd_barrier(const XcdBarrier& b) {
  asm volatile("s_waitcnt vmcnt(0)" ::: "memory");
  __syncthreads();
  if (threadIdx.x == 0) {
    unsigned* bar = b.bar;
    __builtin_amdgcn_s_waitcnt(0);
    unsigned nloc = b.st[0], nx = b.st[1];
    if (nloc == 0u) { xcd_barrier_complete(bar, b.x, nloc, nx); b.st[0] = nloc; b.st[1] = nx; }
    const unsigned old = xb_add(&bar[XB_XSUB(b.x)], 1u);
    const unsigned gen = old / nloc;
    if (old + 1u == (gen + 1u) * nloc) {
      __builtin_amdgcn_fence(__ATOMIC_RELEASE, "agent");
      asm volatile("s_waitcnt vmcnt(0)" ::: "memory");
      const unsigned og = xb_add(&bar[XB_TOP], 1u);
      const unsigned tg = og / nx;
      if (og + 1u == (tg + 1u) * nx) xb_add(&bar[XB_TOPGEN], 1u);
      else XB_SPIN(xb_ld(&bar[XB_TOPGEN]) == tg, bar);
      __builtin_amdgcn_fence(__ATOMIC_ACQUIRE, "agent");
      xb_add(&bar[XB_XGEN(b.x)], 1u);
      asm volatile("s_waitcnt vmcnt(0)" ::: "memory");
    } else {
      XB_SPIN(xb_ld(&bar[XB_XGEN(b.x)]) == gen, bar);
      __builtin_amdgcn_fence(__ATOMIC_ACQUIRE, "agent");
      asm volatile("s_waitcnt vmcnt(0)" ::: "memory");
    }
  }
  __syncthreads();
}

#ifndef ENABLE
#define ENABLE 0xFFFF
#endif
#define EN(bit) if constexpr ((ENABLE >> (bit)) & 1)
__global__ void __launch_bounds__(256, 2) mk(Params p_in, int ph_lo, int ph_hi) {
  extern __shared__ __attribute__((aligned(16))) char smem[];
  __shared__ uint4 sh_misc[2];
  int& s_item = *(int*)&sh_misc[1];
  cg::grid_group grid = cg::this_grid();
  if (threadIdx.x == 0) sh_misc[0] = make_uint4(0u, 0u, 0u, 0u);
  __syncthreads();
  const XcdBarrier xb = xcd_barrier_post((unsigned*)(p_in.ws + OFF_BAR), (volatile LAS unsigned*)&sh_misc[0]);
  grid.sync();
  for (int ph = ph_lo; ph < ph_hi; ++ph) {
    long zoff = 0;
    asm volatile("" : "+s"(zoff));
    Params p;
#pragma unroll
    for (int i = 0; i < 21; ++i) p.in[i] = (const float*)((GLOBAL_AS const float*)(p_in.in[i]));
    p.ws = (char*)((GLOBAL_AS char*)(p_in.ws + zoff));
    p.out = (float*)((GLOBAL_AS float*)(p_in.out + zoff));
    bf16_t* hb = (bf16_t*)(p.ws + OFF_HB);
    bf16_t* wb = (bf16_t*)(p.ws + OFF_WB);
    bf16_t* r0 = (bf16_t*)(p.ws + OFF_R0);
    bf16_t* r1 = (bf16_t*)(p.ws + OFF_R1);
    if (ph == 0) {
      EN(0) { init_phase(p); }
      EN(1) { convert_layer(p, 0, smem); }
    } else {
      const int layer = (ph - 1) / 10, sub = (ph - 1) % 10;
      const int j = layer >> 1;
      const bool even = (layer & 1) == 0;
      if (even && sub >= 3 && sub <= 5) continue;
      if (even) {
        if (sub == 0) {
          EN(2) { gemm_phase(hb, 1024, wb + WB_IN, 1024, 16, smem, EpiEvenIn{r0}); }
        } else if (sub == 1) {
          const float linit = 0.8f - 0.6f * expf(-0.3f * (float)layer);
          EN(4) { attn_phase(p, j, linit, smem, &s_item); }
        } else if (sub == 2) {
          EN(2) { gemm_phase(r1, 1024, wb + WB_OUT, 1024, 8, smem, EpiResid{p}); }
        }
      } else {
        if (sub == 0) {
          EN(2) { gemm_phase(hb, 1024, wb + WB_IN, 1024, 25, smem, EpiOddIn{r0, (float*)(p.ws + OFF_BA)}); }
        } else if (sub == 1) {
          EN(5) { conv_phase(p, j); }
        } else if (sub == 2) {
          EN(6) { for (int it = BIDX; it < NCH * 8; it += gridDim.x) prep_item(p, j, it >> 3, it & 7, smem); }
        } else if (sub == 3) {
          const int nitems = 8 * (8 / NW);
          if ((int)BIDX < nitems) {
            EN(7) { scan_item(p, BIDX / (8 / NW), BIDX % (8 / NW), smem); }
          } else {
            EN(2) { gemm_phase(hb, 1024, wb + WB_Z, 1024, 8, smem, EpiZ{r0 + R0_Z}, nitems); }
          }
        } else if (sub == 4) {
          EN(8) { gate_phase(p, j); }
        } else if (sub == 5) {
          EN(2) { gemm_phase(r1, 3072, wb + WB_OUT, 1024, 8, smem, EpiResid{p}); }
        }
      }
      if (sub == 6) {
        EN(9) { ln_phase(p, p.in[17] + layer * 1024, p.in[18] + layer * 1024); }
      } else if (sub == 7) {
        EN(2) { gemm_phase(hb, 1024, wb + WB_W1, 1024, 32, smem, EpiSqRelu{r0}); }
      } else if (sub == 8) {
        EN(2) { gemm_phase(r0, 4096, wb + WB_W2, 4096, 8, smem, EpiResid{p}); }
      } else if (sub == 9) {
        EN(9) { ln_phase(p, p.in[19] + layer * 1024, p.in[20] + layer * 1024); }
        EN(1) { if (layer < 3) convert_layer(p, layer + 1, smem); }
      }
    }
    if (ph + 1 < ph_hi) xcd_barrier(xb);
  }
}

extern "C" void kernel_launch(void* const* d_in, const int* in_sizes, int n_in, void* d_out, int out_size,
                              void* d_ws, size_t ws_size, hipStream_t stream) {
  static int grid_blocks = 0;
  if (!grid_blocks) {
    int dev = 0, cus = 0, per_cu = 0;
    (void)hipGetDevice(&dev);
    (void)hipDeviceGetAttribute(&cus, hipDeviceAttributeMultiprocessorCount, dev);
    (void)hipFuncSetAttribute((const void*)mk, hipFuncAttributeMaxDynamicSharedMemorySize, SMEM_BYTES);
    (void)hipOccupancyMaxActiveBlocksPerMultiprocessor(&per_cu, mk, 256, SMEM_BYTES);
    if (per_cu > 2) per_cu = 2;
    if (per_cu < 1) per_cu = 1;
    grid_blocks = cus * per_cu;
  }
  Params p{};
  for (int i = 0; i < 21; ++i) p.in[i] = (const float*)d_in[i];
  p.out = (float*)d_out;
  p.ws = (char*)d_ws;
  int lo = 0, hi = 41;
  void* args[] = {&p, &lo, &hi};
  (void)hipMemsetAsync((char*)d_ws + OFF_BAR, 0, 16384, stream);
  (void)hipLaunchCooperativeKernel((void*)mk, dim3(grid_blocks), dim3(256), args, SMEM_BYTES, stream);
}
```

```cpp
#include <hip/hip_runtime.h>
#include <hip/hip_cooperative_groups.h>
namespace cg = cooperative_groups;

typedef unsigned short bf16_t;
using bf16x8 = __attribute__((ext_vector_type(8))) short;
using f32x4 = __attribute__((ext_vector_type(4))) float;
using u32x4 = __attribute__((ext_vector_type(4))) unsigned;
using u32x2 = __attribute__((ext_vector_type(2))) unsigned;
typedef __bf16 bf2_t __attribute__((ext_vector_type(2)));
typedef float f2_t __attribute__((ext_vector_type(2)));

#define DEVI __device__ __forceinline__
#define GLOBAL_AS __attribute__((address_space(1)))

DEVI unsigned xb_xcc_id() { return (unsigned)__builtin_amdgcn_s_getreg((3 << 11) | 20) & 0xFu; }
DEVI int opaque_tid() { int t = threadIdx.x; asm volatile("" : "+v"(t)); return t; }
DEVI int opaque_bid() { int b = blockIdx.x; asm volatile("" : "+s"(b)); return b; }
#define TIDX opaque_tid()
#define BIDX opaque_bid()

constexpr int L = 16400;
constexpr int LR = 16512;
constexpr int NMT = 129;
constexpr int NCH = 257;
constexpr float ALPHA = 1.6817928305074290f;
constexpr float LOG2E = 1.4426950408889634f;

constexpr size_t OFF_HB = 0;
constexpr size_t OFF_WB = 33816576;
constexpr size_t OFF_METAH = 61341696;
constexpr size_t OFF_MISC = 61407232;
constexpr size_t OFF_BA = 61411328;
constexpr size_t OFF_R0 = 62468096;
constexpr size_t OFF_R1 = 163917824;
constexpr size_t OFF_BAR = 265367552;
constexpr size_t WB_IN = 0, WB_Z = 3276800, WB_OUT = 4325376, WB_W1 = 5373952, WB_W2 = 9568256;
constexpr size_t R0_Q = 0, R0_K = 8454144, R0_VT = 16908288, R0_U = 25362432;
constexpr size_t R0_KT = 0, R0_QK = 16842752, R0_G = 25264128, R0_Z = 26100000;

constexpr int SMEM_BYTES = 73728 + 1024;

struct Params {
  const float* in[21];
  float* out;
  char* ws;
};

DEVI unsigned pack2(float a, float b) {
  f2_t v = {a, b};
  bf2_t r = __builtin_convertvector(v, bf2_t);
  return __builtin_bit_cast(unsigned, r);
}
DEVI bf16_t f2bf(float a) { return (bf16_t)(pack2(a, 0.f) & 0xffff); }
DEVI float bf2f(bf16_t b) { return __uint_as_float(((unsigned)b) << 16); }
DEVI float bflo(unsigned u) { return __uint_as_float(u << 16); }
DEVI float bfhi(unsigned u) { return __uint_as_float(u & 0xffff0000u); }

DEVI float* hfrow(const Params& p, int t) {
  return t < 16 ? (float*)(p.ws + OFF_METAH) + t * 1024 : p.out + (size_t)(t - 16) * 1024;
}
DEVI float wave_sum(float v) {
#pragma unroll
  for (int m = 32; m >= 1; m >>= 1) v += __shfl_xor(v, m);
  return v;
}
DEVI bf16x8 mk8(u32x2 a, u32x2 b) {
  u32x4 r = {a.x, a.y, b.x, b.y};
  return __builtin_bit_cast(bf16x8, r);
}
DEVI bf16x8 pack8(f32x4 a, f32x4 b) {
  u32x4 r = {pack2(a[0], a[1]), pack2(a[2], a[3]), pack2(b[0], b[1]), pack2(b[2], b[3])};
  return __builtin_bit_cast(bf16x8, r);
}
DEVI size_t wfm(int n, int k, int K) {
  return ((size_t)(n >> 4) * (K >> 5) + (k >> 5)) * 512 + ((((k >> 3) & 3) << 4) + (n & 15)) * 8 + (k & 7);
}
#define MFMA16(a, b, c) __builtin_amdgcn_mfma_f32_16x16x32_bf16((a), (b), (c), 0, 0, 0)

template <class Epi>
DEVI void gemm_tile(const bf16_t* __restrict__ A, int lda, const bf16_t* __restrict__ Bt, int K,
                    int m0, int n0, char* smem, Epi epi) {
  const int tid = TIDX, lane = tid & 63, wave = tid >> 6;
  const int wm = wave >> 1, wn = wave & 1, l15 = lane & 15, quad = lane >> 4;
  f32x4 acc[4][4];
#pragma unroll
  for (int i = 0; i < 4; ++i)
#pragma unroll
    for (int j = 0; j < 4; ++j) acc[i][j] = f32x4{0.f, 0.f, 0.f, 0.f};
  const int lrow = tid >> 3, lkc = tid & 7;
  const bf16_t* ag = A + (size_t)(m0 + lrow) * lda + lkc * 8;
  const bf16_t* bg = Bt + (size_t)(n0 + lrow) * K + lkc * 8;
  u32x4 ra[4], rb[4];
#pragma unroll
  for (int i = 0; i < 4; ++i) {
    ra[i] = *(const u32x4*)(ag + (size_t)(i * 32) * lda);
    rb[i] = *(const u32x4*)(bg + (size_t)(i * 32) * K);
  }
  const int lds_w = lrow * 128 + ((lkc ^ (lrow & 7)) << 4);
#pragma unroll
  for (int i = 0; i < 4; ++i) {
    *(u32x4*)(smem + lds_w + i * 4096) = ra[i];
    *(u32x4*)(smem + 16384 + lds_w + i * 4096) = rb[i];
  }
  __syncthreads();
  const int nk = K >> 6;
  const int sw = (quad ^ (l15 & 7)) << 4;
  const int a_rd = (wm * 64 + l15) * 128 + sw;
  const int b_rd = 16384 + (wn * 64 + l15) * 128 + sw;
  for (int kt = 0; kt < nk; ++kt) {
    const int buf = (kt & 1) * 32768;
    if (kt + 1 < nk) {
#pragma unroll
      for (int i = 0; i < 4; ++i) {
        ra[i] = *(const u32x4*)(ag + (size_t)(i * 32) * lda + (kt + 1) * 64);
        rb[i] = *(const u32x4*)(bg + (size_t)(i * 32) * K + (kt + 1) * 64);
      }
    }
#pragma unroll
    for (int ks = 0; ks < 2; ++ks) {
      bf16x8 af[4], bf[4];
#pragma unroll
      for (int i = 0; i < 4; ++i) {
        af[i] = *(const bf16x8*)(smem + buf + ((a_rd + i * 2048) ^ (ks * 64)));
        bf[i] = *(const bf16x8*)(smem + buf + ((b_rd + i * 2048) ^ (ks * 64)));
      }
#pragma unroll
      for (int mi = 0; mi < 4; ++mi)
#pragma unroll
        for (int ni = 0; ni < 4; ++ni) acc[mi][ni] = MFMA16(bf[ni], af[mi], acc[mi][ni]);
    }
    if (kt + 1 < nk) {
      const int nb = ((kt + 1) & 1) * 32768;
#pragma unroll
      for (int i = 0; i < 4; ++i) {
        *(u32x4*)(smem + nb + lds_w + i * 4096) = ra[i];
        *(u32x4*)(smem + nb + 16384 + lds_w + i * 4096) = rb[i];
      }
    }
    __syncthreads();
  }
#pragma unroll
  for (int mi = 0; mi < 4; ++mi)
#pragma unroll
    for (int ni = 0; ni < 4; ++ni)
      epi(m0 + wm * 64 + mi * 16 + l15, n0 + wn * 64 + ni * 16 + quad * 4, acc[mi][ni]);
}

template <class Epi>
DEVI void gemm_tile256(const bf16_t* __restrict__ A, int lda, const bf16_t* __restrict__ Bt, int K,
                       int m0, int n0, char* smem, Epi epi) {
  const int tid = TIDX, lane = tid & 63, wave = tid >> 6;
  const int wm = wave >> 1, wn = wave & 1, l15 = lane & 15, quad = lane >> 4;
  f32x4 acc[8][4];
#pragma unroll
  for (int i = 0; i < 8; ++i)
#pragma unroll
    for (int j = 0; j < 4; ++j) acc[i][j] = f32x4{0.f, 0.f, 0.f, 0.f};
  const int lrow = tid >> 3, lkc = tid & 7;
  const bf16_t* ag = A + (size_t)(m0 + lrow) * lda + lkc * 8;
  const bf16_t* bg = Bt + (size_t)(n0 + lrow) * K + lkc * 8;
  u32x4 ra[8], rb[4];
  auto gload = [&](int kt) {
#pragma unroll
    for (int i = 0; i < 8; ++i) ra[i] = *(const u32x4*)(ag + (size_t)(i * 32) * lda + kt * 64);
#pragma unroll
    for (int i = 0; i < 4; ++i) rb[i] = *(const u32x4*)(bg + (size_t)(i * 32) * K + kt * 64);
  };
  const int lds_w = lrow * 128 + ((lkc ^ (lrow & 7)) << 4);
  const int nk = K >> 6;
  const int sw = (quad ^ (l15 & 7)) << 4;
  const int a_rd = (wm * 128 + l15) * 128 + sw;
  const int b_rd = 32768 + (wn * 64 + l15) * 128 + sw;
  gload(0);
  for (int kt = 0; kt < nk; ++kt) {
#pragma unroll
    for (int i = 0; i < 8; ++i) *(u32x4*)(smem + lds_w + i * 4096) = ra[i];
#pragma unroll
    for (int i = 0; i < 4; ++i) *(u32x4*)(smem + 32768 + lds_w + i * 4096) = rb[i];
    __syncthreads();
    if (kt + 1 < nk) gload(kt + 1);
#pragma unroll
    for (int ks = 0; ks < 2; ++ks) {
      bf16x8 af[8], bf[4];
#pragma unroll
      for (int i = 0; i < 4; ++i) bf[i] = *(const bf16x8*)(smem + ((b_rd + i * 2048) ^ (ks * 64)));
#pragma unroll
      for (int i = 0; i < 8; ++i) af[i] = *(const bf16x8*)(smem + ((a_rd + i * 2048) ^ (ks * 64)));
#pragma unroll
      for (int mi = 0; mi < 8; ++mi)
#pragma unroll
        for (int ni = 0; ni < 4; ++ni) acc[mi][ni] = MFMA16(bf[ni], af[mi], acc[mi][ni]);
    }
    __syncthreads();
  }
#pragma unroll
  for (int mi = 0; mi < 8; ++mi)
#pragma unroll
    for (int ni = 0; ni < 4; ++ni)
      epi(m0 + wm * 128 + mi * 16 + l15, n0 + wn * 64 + ni * 16 + quad * 4, acc[mi][ni]);
}

template <class Epi>
DEVI void gemm_tile256b(const bf16_t* __restrict__ A, int lda, const bf16_t* __restrict__ Bt, int K,
                        int m0, int n0, char* smem, Epi epi) {
  const int tid = TIDX, lane = tid & 63, wave = tid >> 6;
  const int wm = wave >> 1, wn = wave & 1, l15 = lane & 15, quad = lane >> 4;
  f32x4 acc[8][4];
#pragma unroll
  for (int i = 0; i < 8; ++i)
#pragma unroll
    for (int j = 0; j < 4; ++j) acc[i][j] = f32x4{0.f, 0.f, 0.f, 0.f};
  const int lrow = tid >> 3, lkc = tid & 7;
  const bf16_t* ag = A + (size_t)(m0 + lrow) * lda + lkc * 8;
  const int kb32 = K >> 5;
  const bf16_t* bp = Bt + ((size_t)((n0 + wn * 64) >> 4) * kb32) * 512 + lane * 8;
  u32x4 ra[8];
  bf16x8 b0[4], b1[4];
  const int lds_w = lrow * 128 + ((lkc ^ (lrow & 7)) << 4);
  const int nk = K >> 6;
  const int sw = (quad ^ (l15 & 7)) << 4;
  const int a_rd = (wm * 128 + l15) * 128 + sw;
#pragma unroll
  for (int i = 0; i < 8; ++i) ra[i] = *(const u32x4*)(ag + (size_t)(i * 32) * lda);
#pragma unroll
  for (int i = 0; i < 4; ++i) b0[i] = *(const bf16x8*)(bp + ((size_t)i * kb32) * 512);
#pragma unroll
  for (int i = 0; i < 8; ++i) *(u32x4*)(smem + lds_w + i * 4096) = ra[i];
  __syncthreads();
  for (int kt = 0; kt < nk; ++kt) {
    const char* base = smem + (kt & 1) * 32768;
    const bool more = kt + 1 < nk;
    if (more) {
#pragma unroll
      for (int i = 0; i < 8; ++i) ra[i] = *(const u32x4*)(ag + (size_t)(i * 32) * lda + (kt + 1) * 64);
    }
#pragma unroll
    for (int i = 0; i < 4; ++i) b1[i] = *(const bf16x8*)(bp + ((size_t)i * kb32 + kt * 2 + 1) * 512);
    {
      bf16x8 af[8];
#pragma unroll
      for (int i = 0; i < 8; ++i) af[i] = *(const bf16x8*)(base + a_rd + i * 2048);
#pragma unroll
      for (int mi = 0; mi < 8; ++mi)
#pragma unroll
        for (int ni = 0; ni < 4; ++ni) acc[mi][ni] = MFMA16(b0[ni], af[mi], acc[mi][ni]);
    }
    if (more) {
#pragma unroll
      for (int i = 0; i < 4; ++i) b0[i] = *(const bf16x8*)(bp + ((size_t)i * kb32 + kt * 2 + 2) * 512);
    }
    {
      bf16x8 af[8];
#pragma unroll
      for (int i = 0; i < 8; ++i) af[i] = *(const bf16x8*)(base + ((a_rd + i * 2048) ^ 64));
#pragma unroll
      for (int mi = 0; mi < 8; ++mi)
#pragma unroll
        for (int ni = 0; ni < 4; ++ni) acc[mi][ni] = MFMA16(b1[ni], af[mi], acc[mi][ni]);
    }
    if (more) {
      char* nb = smem + ((kt + 1) & 1) * 32768 + lds_w;
#pragma unroll
      for (int i = 0; i < 8; ++i) *(u32x4*)(nb + i * 4096) = ra[i];
    }
    __syncthreads();
  }
#pragma unroll
  for (int mi = 0; mi < 8; ++mi)
#pragma unroll
    for (int ni = 0; ni < 4; ++ni)
      epi(m0 + wm * 128 + mi * 16 + l15, n0 + wn * 64 + ni * 16 + quad * 4, acc[mi][ni]);
}

template <class Epi>
DEVI void gemm_tail_tile(const bf16_t* __restrict__ A, int lda, const bf16_t* __restrict__ Bt, int K, int n0,
                         char* smem, Epi epi) {
  const int tid = TIDX, lane = tid & 63, wave = tid >> 6, l15 = lane & 15, quad = lane >> 4;
  constexpr int M0 = 16384;
  f32x4 acc[8];
#pragma unroll
  for (int i = 0; i < 8; ++i) acc[i] = f32x4{0.f, 0.f, 0.f, 0.f};
  const int kq = K >> 2;
  const bf16_t* ag = A + (size_t)(M0 + l15) * lda + wave * kq + quad * 8;
  const int kb32 = K >> 5;
  const bf16_t* bg = Bt + ((size_t)(n0 >> 4) * kb32 + ((wave * kq) >> 5)) * 512 + lane * 8;
  bf16x8 a0, a1, b0[8], b1[8];
  auto tload = [&](bf16x8& a, bf16x8 (&b)[8], int k) {
    a = *(const bf16x8*)(ag + k);
#pragma unroll
    for (int nt = 0; nt < 8; ++nt) b[nt] = *(const bf16x8*)(bg + ((size_t)nt * kb32 + (k >> 5)) * 512);
  };
  tload(a0, b0, 0);
  tload(a1, b1, 32);
  for (int k = 0; k < kq; k += 64) {
#pragma unroll
    for (int nt = 0; nt < 8; ++nt) acc[nt] = MFMA16(b0[nt], a0, acc[nt]);
    if (k + 64 < kq) tload(a0, b0, k + 64);
#pragma unroll
    for (int nt = 0; nt < 8; ++nt) acc[nt] = MFMA16(b1[nt], a1, acc[nt]);
    if (k + 96 < kq) tload(a1, b1, k + 96);
  }
  f32x4* red = (f32x4*)smem;
#pragma unroll
  for (int nt = 0; nt < 8; ++nt) red[(wave * 8 + nt) * 64 + lane] = acc[nt];
  __syncthreads();
#pragma unroll
  for (int q = 0; q < 2; ++q) {
    const int nt = wave * 2 + q;
    f32x4 v = red[(0 * 8 + nt) * 64 + lane] + red[(1 * 8 + nt) * 64 + lane] + red[(2 * 8 + nt) * 64 + lane] +
              red[(3 * 8 + nt) * 64 + lane];
    epi(M0 + l15, n0 + nt * 16 + quad * 4, v);
  }
  __syncthreads();
}

template <class Epi>
DEVI void gemm_phase(const bf16_t* A, int lda, const bf16_t* Bt, int K, int nnt, char* smem, Epi epi,
                     int skip = 0) {
  const int nmain = 64 * nnt, ntiles = nmain + nnt;
  const int nb = gridDim.x - skip;
  const int b = BIDX - skip;
  const bool xmap = (skip == 0) && ((nnt & 7) == 0) && ((nb & 63) == 0);
  const int q = xmap ? (b & 7) * (nb >> 3) + (b >> 3) : b;
  for (int t0 = 0; t0 < ntiles; t0 += nb) {
    const int t = t0 + q;
    if (t >= ntiles) break;
    if (t < nmain) {
      int mt, nt;
      if (xmap) {
        const int s_ = t >> 6, w_ = t & 63, spr = nnt >> 3;
        const int sm = s_ / spr, sn = s_ - sm * spr;
        mt = sm * 8 + (w_ >> 3);
        nt = sn * 8 + (w_ & 7);
      } else {
        mt = t / nnt;
        nt = t - mt * nnt;
      }
      gemm_tile256b(A, lda, Bt, K, mt * 256, nt * 128, smem, epi);
    } else {
      gemm_tail_tile(A, lda, Bt, K, (t - nmain) * 128, smem, epi);
    }
  }
}

struct EpiEvenIn {
  bf16_t* r0;
  DEVI void operator()(int m, int n, f32x4 v) const {
    if (n < 1024) {
      if (m >= L) return;
      const bool isq = n < 512;
      const int nn = n & 511;
      const int h = nn >> 7, c = (nn >> 6) & 1, d = nn & 63;
      const float s = isq ? (0.125f * LOG2E) : 1.0f;
      bf16_t* dst = isq ? r0 + R0_Q + ((size_t)(h * 2 + c) * LR + m) * 64 + d
                        : r0 + R0_K + (size_t)(h * 2 + c) * LR * 64 + wfm(m, d, 64);
      *(u32x2*)dst = u32x2{pack2(v[0] * s, v[1] * s), pack2(v[2] * s, v[3] * s)};
    } else if (n < 1536) {
      const int nn = n - 1024;
      bf16_t* dst = r0 + R0_VT + (size_t)nn * LR + m;
      const bool ok = m < L;
#pragma unroll
      for (int i = 0; i < 4; ++i) {
        dst[(size_t)i * LR] = ok ? f2bf(v[i]) : (bf16_t)0;
        if (m >= 16384) {
          dst[(size_t)i * LR + 16] = 0;
          dst[(size_t)i * LR + 32] = 0;
          dst[(size_t)i * LR + 48] = 0;
        }
      }
    } else {
      if (m >= L) return;
      bf16_t* dst = r0 + R0_U + (size_t)m * 512 + (n - 1536);
      *(u32x2*)dst = u32x2{pack2(v[0], v[1]), pack2(v[2], v[3])};
    }
  }
};
struct EpiResid {
  Params p;
  DEVI void operator()(int m, int n, f32x4 v) const {
    if (m >= L) return;
    float* h = hfrow(p, m) + n;
    f32x4 o = *(f32x4*)h;
    o = o * ALPHA + v;
    *(f32x4*)h = o;
  }
};
struct EpiOddIn {
  bf16_t* raw;
  float* ba;
  DEVI void operator()(int m, int n, f32x4 v) const {
    if (m >= L) return;
    if (n < 3072) {
      *(u32x2*)(raw + (size_t)m * 3072 + n) = u32x2{pack2(v[0], v[1]), pack2(v[2], v[3])};
    } else if (n < 3088) {
      *(f32x4*)(ba + (size_t)m * 16 + (n - 3072)) = v;
    }
  }
};
struct EpiZ {
  bf16_t* z;
  DEVI void operator()(int m, int n, f32x4 v) const {
    if (m >= L) return;
    *(u32x2*)(z + (size_t)m * 1024 + n) = u32x2{pack2(v[0], v[1]), pack2(v[2], v[3])};
  }
};
struct EpiSqRelu {
  bf16_t* hid;
  DEVI void operator()(int m, int n, f32x4 v) const {
    if (m >= L) return;
    float a = fmaxf(v[0], 0.f), b = fmaxf(v[1], 0.f), c = fmaxf(v[2], 0.f), d = fmaxf(v[3], 0.f);
    *(u32x2*)(hid + (size_t)m * 4096 + n) = u32x2{pack2(a * a, b * b), pack2(c * c, d * d)};
  }
};

DEVI void tconv_seg(const float* src, int ld, int krows, int c0, int ncols, int ndst, bf16_t* dst, int dld,
                    char* smem) {
  float* tile = (float*)smem;
  const int tid = TIDX;
  const int nkt = krows >> 6, nnt = (ndst + 63) >> 6;
  const int lr = tid >> 4, lc = (tid & 15) * 4;
  const int kp = tid & 31, wn = tid >> 5;
  for (int t = BIDX; t < nkt * nnt; t += gridDim.x) {
    const int kt = t % nkt, nt = t / nkt;
    const int k0 = kt * 64, n0 = nt * 64;
#pragma unroll
    for (int i = 0; i < 4; ++i) {
      const int r = i * 16 + lr;
      f32x4 v = f32x4{0.f, 0.f, 0.f, 0.f};
      if (n0 + lc < ncols) v = *(const f32x4*)(src + (size_t)(k0 + r) * ld + c0 + n0 + lc);
      tile[r * 65 + lc + 0] = v[0];
      tile[r * 65 + lc + 1] = v[1];
      tile[r * 65 + lc + 2] = v[2];
      tile[r * 65 + lc + 3] = v[3];
    }
    __syncthreads();
#pragma unroll
    for (int i = 0; i < 8; ++i) {
      const int rn = i * 8 + wn;
      if (n0 + rn < ndst)
        *(unsigned*)(dst + wfm(n0 + rn, k0 + 2 * kp, dld)) = pack2(tile[(2 * kp) * 65 + rn], tile[(2 * kp + 1) * 65 + rn]);
    }
    __syncthreads();
  }
}

DEVI void convert_layer(const Params& p, int layer, char* smem) {
  bf16_t* wb = (bf16_t*)(p.ws + OFF_WB);
  const int j = layer >> 1;
  if ((layer & 1) == 0) {
    tconv_seg(p.in[3] + (size_t)j * 1024 * 2048, 2048, 1024, 0, 2048, 2048, wb + WB_IN, 1024, smem);
    tconv_seg(p.in[8] + (size_t)j * 1024 * 1024, 1024, 512, 0, 1024, 1024, wb + WB_OUT, 1024, smem);
    const float* pw = p.in[6] + (size_t)j * 4 * 128 * 128;
    const float* ps = p.in[7] + (size_t)j * 512;
    const float* wo = p.in[8] + (size_t)j * 1024 * 1024;
    {
      const int tid = TIDX;
      for (int item = BIDX; item < 512; item += gridDim.x) {
        const int g = item >> 7, c = item & 127;
        const float* pwr = pw + ((size_t)g * 128 + c) * 128;
        const float* wor = wo + (size_t)(512 + g * 128) * 1024 + tid * 4;
        f32x4 acc = f32x4{0.f, 0.f, 0.f, 0.f};
#pragma unroll 8
        for (int d = 0; d < 128; ++d) {
          const float a = pwr[d] * ps[g * 128 + d];
          const f32x4 w4 = *(const f32x4*)(wor + (size_t)d * 1024);
          acc = acc + w4 * a;
        }
#pragma unroll
        for (int e = 0; e < 4; ++e) wb[WB_OUT + wfm(tid * 4 + e, 512 + item, 1024)] = f2bf(acc[e]);
      }
    }
  } else {
    const float* wi = p.in[9] + (size_t)j * 1024 * 4112;
    tconv_seg(wi, 4112, 1024, 0, 3072, 3072, wb + WB_IN, 1024, smem);
    tconv_seg(wi, 4112, 1024, 4096, 16, 128, wb + WB_IN + (size_t)3072 * 1024, 1024, smem);
    tconv_seg(wi, 4112, 1024, 3072, 1024, 1024, wb + WB_Z, 1024, smem);
    tconv_seg(p.in[14] + (size_t)j * 1024 * 1024, 1024, 1024, 0, 1024, 1024, wb + WB_OUT, 1024, smem);
  }
  tconv_seg(p.in[15] + (size_t)layer * 1024 * 4096, 4096, 1024, 0, 4096, 4096, wb + WB_W1, 1024, smem);
  tconv_seg(p.in[16] + (size_t)layer * 4096 * 1024, 1024, 4096, 0, 1024, 1024, wb + WB_W2, 4096, smem);
}

DEVI void init_phase(const Params& p) {
  const int gt = BIDX * 256 + TIDX, nth = gridDim.x * 256;
  if (gt < 64) ((int*)(p.ws + OFF_MISC))[gt] = 0;
  bf16_t* hb = (bf16_t*)(p.ws + OFF_HB);
  for (int idx = gt; idx < L * 256; idx += nth) {
    const int t = idx >> 8, c = (idx & 255) * 4;
    f32x4 v = (t < 16) ? *(const f32x4*)(p.in[1] + t * 1024 + c) : *(const f32x4*)(p.in[0] + (size_t)(t - 16) * 1024 + c);
    *(f32x4*)(hfrow(p, t) + c) = v;
    *(u32x2*)(hb + (size_t)t * 1024 + c) = u32x2{pack2(v[0], v[1]), pack2(v[2], v[3])};
  }
}

DEVI void ln_phase(const Params& p, const float* g, const float* b) {
  const int tid = TIDX;
  const int lane = tid & 63;
  const int gw = BIDX * 4 + (tid >> 6), nw = gridDim.x * 4;
  bf16_t* hb = (bf16_t*)(p.ws + OFF_HB);
  for (int t0 = gw * 4; t0 < L; t0 += nw * 4) {
    f32x4 v[4][4];
    float* h[4];
#pragma unroll
    for (int r = 0; r < 4; ++r) {
      h[r] = hfrow(p, t0 + r);
#pragma unroll
      for (int i = 0; i < 4; ++i) v[r][i] = *(const f32x4*)(h[r] + i * 256 + lane * 4);
    }
    float s[4], q[4];
#pragma unroll
    for (int r = 0; r < 4; ++r) {
      s[r] = 0.f;
#pragma unroll
      for (int i = 0; i < 4; ++i) s[r] += v[r][i][0] + v[r][i][1] + v[r][i][2] + v[r][i][3];
    }
#pragma unroll
    for (int m = 32; m >= 1; m >>= 1) {
#pragma unroll
      for (int r = 0; r < 4; ++r) s[r] += __shfl_xor(s[r], m);
    }
#pragma unroll
    for (int r = 0; r < 4; ++r) {
      const float mu = s[r] * (1.f / 1024.f);
      q[r] = 0.f;
#pragma unroll
      for (int i = 0; i < 4; ++i) {
        v[r][i] = v[r][i] - mu;
        q[r] += v[r][i][0] * v[r][i][0] + v[r][i][1] * v[r][i][1] + v[r][i][2] * v[r][i][2] + v[r][i][3] * v[r][i][3];
      }
    }
#pragma unroll
    for (int m = 32; m >= 1; m >>= 1) {
#pragma unroll
      for (int r = 0; r < 4; ++r) q[r] += __shfl_xor(q[r], m);
    }
#pragma unroll
    for (int i = 0; i < 4; ++i) {
      const f32x4 gg = *(const f32x4*)(g + i * 256 + lane * 4);
      const f32x4 bb = *(const f32x4*)(b + i * 256 + lane * 4);
#pragma unroll
      for (int r = 0; r < 4; ++r) {
        const float rstd = rsqrtf(q[r] * (1.f / 1024.f) + 1e-5f);
        f32x4 y = v[r][i] * rstd * gg + bb;
        *(f32x4*)(h[r] + i * 256 + lane * 4) = y;
        *(u32x2*)(hb + (size_t)(t0 + r) * 1024 + i * 256 + lane * 4) = u32x2{pack2(y[0], y[1]), pack2(y[2], y[3])};
      }
    }
  }
}

DEVI void pool_phase(const Params& p) {
  const bf16_t* U = (const bf16_t*)(p.ws + OFF_R0) + R0_U;
  bf16_t* cat = (bf16_t*)(p.ws + OFF_R1);
  const int gt = BIDX * 256 + TIDX, nth = gridDim.x * 256;
  for (int idx = gt; idx < L * 64; idx += nth) {
    const int t = idx >> 6, cc = idx & 63, g = cc >> 4;
    const int win = 2 << g;
    const int cnt = min(t + 1, win);
    float s[8];
#pragma unroll
    for (int e = 0; e < 8; ++e) s[e] = 0.f;
    u32x4 self = u32x4{0, 0, 0, 0};
    u32x4 tv[16];
#pragma unroll
    for (int k = 0; k < 16; ++k) {
      tv[k] = u32x4{0, 0, 0, 0};
      if (k < cnt) tv[k] = *(const u32x4*)(U + (size_t)(t - k) * 512 + cc * 8);
    }
    self = tv[0];
#pragma unroll
    for (int k = 0; k < 16; ++k) {
#pragma unroll
      for (int e = 0; e < 4; ++e) {
        s[2 * e] += bflo(tv[k][e]);
        s[2 * e + 1] += bfhi(tv[k][e]);
      }
    }
    const float inv = 1.f / (float)cnt;
    u32x4 o;
#pragma unroll
    for (int e = 0; e < 4; ++e) o[e] = pack2(s[2 * e] * inv - bflo(self[e]), s[2 * e + 1] * inv - bfhi(self[e]));
    *(u32x4*)(cat + (size_t)t * 1024 + 512 + cc * 8) = o;
  }
}

DEVI void attn_item(const Params& p, int j, int h, int qt, float lam, float one_m_linit, char* smem) {
  const int tid = TIDX, lane = tid & 63, wave = tid >> 6;
  const int rg = wave & 1, c = wave >> 1, l15 = lane & 15, quad = lane >> 4;
  const bf16_t* r0 = (const bf16_t*)(p.ws + OFF_R0);
  const bf16_t* Qg = r0 + R0_Q + (size_t)(h * 2 + c) * LR * 64;
  const bf16_t* Kfm = r0 + R0_K + (size_t)(h * 2 + c) * LR * 64 + lane * 8;
  const bf16_t* Vg = r0 + R0_VT + (size_t)(h * 128) * LR;
  const float* tbl = (const float*)(smem + 73728);
  const int q0 = qt * 64;
  const int qw = q0 + rg * 32;
  bf16x8 qf[2][2];
#pragma unroll
  for (int qi = 0; qi < 2; ++qi)
#pragma unroll
    for (int ks = 0; ks < 2; ++ks)
      qf[qi][ks] = *(const bf16x8*)(Qg + (size_t)(qw + qi * 16 + l15) * 64 + ks * 32 + quad * 8);
  f32x4 oacc[2][8];
#pragma unroll
  for (int qi = 0; qi < 2; ++qi)
#pragma unroll
    for (int d = 0; d < 8; ++d) oacc[qi][d] = f32x4{0.f, 0.f, 0.f, 0.f};
  float mrun[2] = {0.f, 0.f};
  f32x4 lacc[2] = {f32x4{0.f, 0.f, 0.f, 0.f}, f32x4{0.f, 0.f, 0.f, 0.f}};
  const bf16x8 ones = {16256, 16256, 16256, 16256, 16256, 16256, 16256, 16256};
  const int nkt = qt + 1;
  const int krow = tid >> 3, kkc = tid & 7;
  u32x4 rv[4];
  auto gload = [&](int kt) {
    const int k0 = kt * 64;
#pragma unroll
    for (int i = 0; i < 4; ++i) rv[i] = *(const u32x4*)(Vg + (size_t)(krow + i * 32) * LR + k0 + kkc * 8);
  };
  auto lstore = [&](int buf) {
    char* b = smem + buf * 34816;
#pragma unroll
    for (int i = 0; i < 4; ++i) *(u32x4*)(b + 16384 + (krow + i * 32) * 144 + kkc * 16) = rv[i];
  };
  bf16x8 kf[4][2];
  auto kload = [&](int kt) {
#pragma unroll
    for (int ki = 0; ki < 4; ++ki)
#pragma unroll
      for (int ks = 0; ks < 2; ++ks) kf[ki][ks] = *(const bf16x8*)(Kfm + ((size_t)((kt * 4 + ki) * 2 + ks)) * 512);
  };
  gload(0);
  kload(0);
  lstore(0);
  __syncthreads();
  for (int kt = 0; kt < nkt; ++kt) {
    const char* b = smem + (kt & 1) * 34816;
    if (kt + 1 < nkt) gload(kt + 1);
    const int k0 = kt * 64;
    if (k0 <= qw + 31) {
      f32x4 st[2][4];
#pragma unroll
      for (int qi = 0; qi < 2; ++qi)
#pragma unroll
        for (int ki = 0; ki < 4; ++ki) st[qi][ki] = f32x4{-mrun[qi], -mrun[qi], -mrun[qi], -mrun[qi]};
      const char* vb = b + 16384;
      bf16x8 vf[2][4];
      auto vload = [&](int g, int slot) {
#pragma unroll
        for (int dd = 0; dd < 2; ++dd)
#pragma unroll
          for (int s2 = 0; s2 < 2; ++s2) {
            const char* a = vb + ((g * 2 + dd) * 16 + l15) * 144 + s2 * 64 + quad * 8;
            vf[slot][dd * 2 + s2] = mk8(*(const u32x2*)a, *(const u32x2*)(a + 32));
          }
      };
      __builtin_amdgcn_s_setprio(2);
#pragma unroll
      for (int ki = 0; ki < 4; ++ki)
#pragma unroll
        for (int ks = 0; ks < 2; ++ks) {
#pragma unroll
          for (int qi = 0; qi < 2; ++qi) st[qi][ki] = MFMA16(kf[ki][ks], qf[qi][ks], st[qi][ki]);
        }
      __builtin_amdgcn_s_setprio(0);
      if (kt + 1 < nkt) kload(kt + 1);
      __builtin_amdgcn_sched_barrier(0);
      const bool far = (qw - (k0 + 63)) >= 128;
      const bool first = (kt == 0);
#pragma unroll
      for (int qi = 0; qi < 2; ++qi) {
        if (!far) {
          const int qpos = qw + qi * 16 + l15;
#pragma unroll
          for (int ki = 0; ki < 4; ++ki)
#pragma unroll
            for (int jj = 0; jj < 4; ++jj) {
              const int n = qpos - (k0 + ki * 16 + quad * 4 + jj);
              st[qi][ki][jj] = (n >= 0) ? st[qi][ki][jj] + tbl[min(n, 128)] : -1e30f;
            }
        }
        float tmax = st[qi][0][0];
#pragma unroll
        for (int ki = 0; ki < 4; ++ki)
#pragma unroll
          for (int jj = 0; jj < 4; jj += 2) tmax = fmaxf(fmaxf(tmax, st[qi][ki][jj]), st[qi][ki][jj + 1]);
        tmax = fmaxf(tmax, __shfl_xor(tmax, 16));
        tmax = fmaxf(tmax, __shfl_xor(tmax, 32));
        if (first || __any(tmax > 8.0f)) {
          const float dm = first ? tmax : fmaxf(tmax, 0.f);
          const float alpha = __builtin_amdgcn_exp2f(-dm);
          mrun[qi] += dm;
          lacc[qi] = lacc[qi] * alpha;
#pragma unroll
          for (int d = 0; d < 8; ++d) oacc[qi][d] = oacc[qi][d] * alpha;
#pragma unroll
          for (int ki = 0; ki < 4; ++ki) st[qi][ki] = st[qi][ki] - dm;
        }
#pragma unroll
        for (int ki = 0; ki < 4; ++ki)
#pragma unroll
          for (int jj = 0; jj < 4; ++jj) st[qi][ki][jj] = __builtin_amdgcn_exp2f(st[qi][ki][jj]);
      }
      vload(0, 0);
      bf16x8 pb[2][2];
#pragma unroll
      for (int qi = 0; qi < 2; ++qi)
#pragma unroll
        for (int s2 = 0; s2 < 2; ++s2) pb[qi][s2] = pack8(st[qi][2 * s2], st[qi][2 * s2 + 1]);
      __builtin_amdgcn_s_setprio(2);
#pragma unroll
      for (int qi = 0; qi < 2; ++qi)
#pragma unroll
        for (int s2 = 0; s2 < 2; ++s2) lacc[qi] = MFMA16(ones, pb[qi][s2], lacc[qi]);
#pragma unroll
      for (int g = 0; g < 4; ++g) {
        if (g < 3) vload(g + 1, (g + 1) & 1);
#pragma unroll
        for (int dd = 0; dd < 2; ++dd)
#pragma unroll
          for (int s2 = 0; s2 < 2; ++s2)
#pragma unroll
            for (int qi = 0; qi < 2; ++qi)
              oacc[qi][g * 2 + dd] = MFMA16(vf[g & 1][dd * 2 + s2], pb[qi][s2], oacc[qi][g * 2 + dd]);
        __builtin_amdgcn_sched_barrier(0);
      }
      __builtin_amdgcn_s_setprio(0);
    }
    if (kt + 1 < nkt) lstore((kt + 1) & 1);
    __syncthreads();
  }
#pragma unroll
  for (int qi = 0; qi < 2; ++qi) {
    const float inv = 1.f / lacc[qi][0];
#pragma unroll
    for (int d = 0; d < 8; ++d) oacc[qi][d] = oacc[qi][d] * inv;
  }
  f32x4* xb = (f32x4*)smem;
  if (c == 1) {
#pragma unroll
    for (int qi = 0; qi < 2; ++qi)
#pragma unroll
      for (int d = 0; d < 8; ++d) xb[((rg * 2 + qi) * 8 + d) * 64 + lane] = oacc[qi][d];
  }
  __syncthreads();
  if (c == 0) {
    const float* sw = p.in[5] + j * 128;
    bf16_t* cat = (bf16_t*)(p.ws + OFF_R1);
#pragma unroll
    for (int qi = 0; qi < 2; ++qi) {
      float ss = 0.f;
#pragma unroll
      for (int d = 0; d < 8; ++d) {
        f32x4 o1 = xb[((rg * 2 + qi) * 8 + d) * 64 + lane];
        f32x4 o = oacc[qi][d] - o1 * lam;
        oacc[qi][d] = o;
        ss += o[0] * o[0] + o[1] * o[1] + o[2] * o[2] + o[3] * o[3];
      }
      ss += __shfl_xor(ss, 16);
      ss += __shfl_xor(ss, 32);
      const float r = rsqrtf(ss * (1.f / 128.f) + 1e-6f) * one_m_linit;
      const int qpos = qw + qi * 16 + l15;
      if (qpos < L) {
#pragma unroll
        for (int d = 0; d < 8; ++d) {
          const int dv = d * 16 + quad * 4;
          f32x4 w = *(const f32x4*)(sw + dv);
          f32x4 o = oacc[qi][d] * r * w;
          *(u32x2*)(cat + (size_t)qpos * 1024 + h * 128 + dv) = u32x2{pack2(o[0], o[1]), pack2(o[2], o[3])};
        }
      }
    }
  }
  __syncthreads();
}

DEVI void attn_phase(const Params& p, int j, float lambda_init, char* smem, int* s_item) {
  const int tid = TIDX;
  const float* lv = p.in[4] + j * 256;
  float d01 = 0.f, d23 = 0.f;
  for (int i = 0; i < 64; ++i) {
    d01 += lv[i] * lv[64 + i];
    d23 += lv[128 + i] * lv[192 + i];
  }
  const float lam = expf(d01) - expf(d23) + lambda_init;
  float* tbl = (float*)(smem + 73728);
  int cur_h = -1;
  const int x0 = (int)(xb_xcc_id() & 7u);
  for (int qx = 0; qx < 8; ++qx) {
    const int xq = (x0 + qx) & 7;
    int* counter = (int*)(p.ws + OFF_MISC) + 16 + j * 8 + xq;
    const int h = xq >> 1, par = xq & 1, nq = par ? 128 : 129;
    for (;;) {
      if (tid == 0) *s_item = atomicAdd(counter, 1);
      __syncthreads();
      const int item = *s_item;
      __syncthreads();
      if (item >= nq) break;
      const int qt = (par ? 255 : 256) - 2 * item;
      if (h != cur_h) {
        if (tid < 129) {
          int bucket;
          if (tid < 16) bucket = tid;
          else {
            bucket = 16 + (int)(logf((float)tid / 16.0f) / 2.0794415416798357f * 16.0f);
            bucket = min(bucket, 31);
          }
          tbl[tid] = (p.in[2][bucket * 4 + h] - p.in[2][31 * 4 + h]) * LOG2E;
        }
        cur_h = h;
        __syncthreads();
      }
      attn_item(p, j, h, qt, lam, 1.0f - lambda_init, smem);
    }
  }
}

DEVI void conv_phase(const Params& p, int j) {
  const bf16_t* raw = (const bf16_t*)(p.ws + OFF_R0);
  bf16_t* r1 = (bf16_t*)(p.ws + OFF_R1);
  const float* cw = p.in[10] + (size_t)j * 3072 * 4;
  const int tid = TIDX;
  const int lane = tid & 63;
  const int gw = BIDX * 4 + (tid >> 6), nw = gridDim.x * 4;
  for (int item = gw; item < 1025 * 24; item += nw) {
    const int run = item / 24, seg = item - run * 24;
    const int tb = run * 16;
    const int ch = seg * 128 + lane * 2;
    const f32x4 w0 = *(const f32x4*)(cw + (size_t)ch * 4);
    const f32x4 w1 = *(const f32x4*)(cw + (size_t)ch * 4 + 4);
    unsigned xv[19];
#pragma unroll
    for (int r = 0; r < 19; ++r) {
      const int tt = tb - 3 + r;
      xv[r] = 0;
      if (tt >= 0) xv[r] = *(const unsigned*)(raw + (size_t)tt * 3072 + ch);
    }
    float y0[16], y1[16], ss[16];
#pragma unroll
    for (int i = 0; i < 16; ++i) {
      float a0 = 0.f, a1 = 0.f;
#pragma unroll
      for (int k = 0; k < 4; ++k) {
        a0 += w0[k] * bflo(xv[i + k]);
        a1 += w1[k] * bfhi(xv[i + k]);
      }
      a0 = a0 / (1.f + __expf(-a0));
      a1 = a1 / (1.f + __expf(-a1));
      y0[i] = a0;
      y1[i] = a1;
      ss[i] = a0 * a0 + a1 * a1;
    }
    if (seg < 16) {
#pragma unroll
      for (int m = 32; m >= 1; m >>= 1) {
#pragma unroll
        for (int i = 0; i < 16; ++i) ss[i] += __shfl_xor(ss[i], m);
      }
      const float sc = (seg < 8) ? 0.08838834764831845f : 1.0f;
#pragma unroll
      for (int i = 0; i < 16; ++i) {
        const float r = rsqrtf(ss[i] + 1e-6f) * sc;
        y0[i] *= r;
        y1[i] *= r;
      }
    }
    int chw = ch;
    if (seg < 8) {
      const int cc = lane * 2;
      chw = seg * 128 + (cc & 96) + (((cc >> 2) & 3) << 3) + (((cc >> 4) & 1) << 2) + (cc & 3);
    }
#pragma unroll
    for (int i = 0; i < 16; ++i) *(unsigned*)(r1 + (size_t)(tb + i) * 3072 + chw) = pack2(y0[i], y1[i]);
  }
}

DEVI void prep_item(const Params& p, int j, int n, int h, char* smem) {
  const int tid = TIDX, lane = tid & 63, wave = tid >> 6, l15 = lane & 15, quad = lane >> 4;
  bf16_t* r1 = (bf16_t*)(p.ws + OFF_R1);
  bf16_t* r0 = (bf16_t*)(p.ws + OFF_R0);
  const float* ba = (const float*)(p.ws + OFF_BA);
  char* qs = smem;
  char* ks = smem + 17408;
  char* vs = smem + 34816;
  float* am = (float*)(smem + 52224);
  float* sbeta = (float*)(smem + 69632);
  float* sgc = sbeta + 64;
  const int t0 = n * 64 - 48;
#pragma unroll
  for (int i = 0; i < 4; ++i) {
    const int ch = tid + i * 256, row = ch >> 4, kc = ch & 15;
    const int t = t0 + row;
    u32x4 vq = u32x4{0, 0, 0, 0}, vk = vq, vv = vq;
    if (t >= 0) {
      const bf16_t* src = r1 + (size_t)t * 3072 + h * 128 + kc * 8;
      vq = *(const u32x4*)src;
      vk = *(const u32x4*)(src + 1024);
      vv = *(const u32x4*)(src + 2048);
    }
    {
      const int s_ = kc >> 2, q_ = kc & 3;
      *(u32x2*)(qs + row * 272 + (s_ * 32 + q_ * 4) * 2) = u32x2{vq.x, vq.y};
      *(u32x2*)(qs + row * 272 + (s_ * 32 + 16 + q_ * 4) * 2) = u32x2{vq.z, vq.w};
    }
    *(u32x4*)(ks + row * 272 + kc * 16) = vk;
    *(u32x4*)(vs + row * 272 + kc * 16) = vv;
  }
  if (wave == 0) {
    const int t = t0 + lane;
    float beta = 0.f, g = 0.f;
    if (t >= 0) {
      const float braw = ba[(size_t)t * 16 + h], araw = ba[(size_t)t * 16 + 8 + h];
      beta = 1.f / (1.f + expf(-braw));
      const float x = araw + p.in[12][j * 8 + h];
      const float sp = (x > 20.f) ? x : log1pf(expf(x));
      g = -expf(p.in[11][j * 8 + h]) * sp;
    }
#pragma unroll
    for (int off = 1; off < 64; off <<= 1) {
      const float o = __shfl_up(g, off);
      if (lane >= off) g += o;
    }
    sbeta[lane] = beta;
    sgc[lane] = g;
    {
      const float glast = __shfl(g, 63);
      float* gout = (float*)(r0 + R0_G) + (size_t)(n * 8 + h) * 192;
      gout[lane] = __expf(g);
      gout[64 + lane] = __expf(glast - g);
      if (lane == 0) gout[128] = __expf(glast);
    }
  }
  __syncthreads();
  {
    f32x4 akk[4], aqk[4];
#pragma unroll
    for (int nt = 0; nt < 4; ++nt) akk[nt] = aqk[nt] = f32x4{0.f, 0.f, 0.f, 0.f};
#pragma unroll
    for (int s = 0; s < 4; ++s) {
      bf16x8 ka = *(const bf16x8*)(ks + (wave * 16 + l15) * 272 + s * 64 + quad * 16);
      bf16x8 qa = *(const bf16x8*)(qs + (wave * 16 + l15) * 272 + s * 64 + quad * 16);
#pragma unroll
      for (int nt = 0; nt < 4; ++nt) {
        bf16x8 kb = *(const bf16x8*)(ks + (nt * 16 + l15) * 272 + s * 64 + quad * 16);
        akk[nt] = MFMA16(ka, kb, akk[nt]);
        aqk[nt] = MFMA16(qa, kb, aqk[nt]);
      }
    }
    bf16_t* qkout = r0 + R0_QK + (size_t)(n * 8 + h) * 4096;
#pragma unroll
    for (int nt = 0; nt < 4; ++nt) {
      const int jx = nt * 16 + l15;
      const float gj = sgc[jx];
#pragma unroll
      for (int jj = 0; jj < 4; ++jj) {
        const int i = wave * 16 + quad * 4 + jj;
        const float dec = __expf(fminf(sgc[i] - gj, 0.f));
        am[i * 68 + jx] = (jx < i) ? sbeta[i] * akk[nt][jj] * dec : 0.f;
        qkout[i * 64 + jx] = f2bf((jx <= i) ? aqk[nt][jj] * dec : 0.f);
      }
    }
  }
  __syncthreads();
  {
    bf16_t* kt = r0 + R0_KT + (size_t)(n * 8 + h) * 8192;
#pragma unroll
    for (int i = 0; i < 4; ++i) {
      const int unit = tid + i * 256, d = unit >> 3, i0 = (unit & 7) * 8;
      unsigned e[8];
#pragma unroll
      for (int q = 0; q < 8; ++q) e[q] = *(const unsigned short*)(ks + (i0 + q) * 272 + d * 2);
      u32x4 o = {e[0] | (e[1] << 16), e[2] | (e[3] << 16), e[4] | (e[5] << 16), e[6] | (e[7] << 16)};
      *(u32x4*)(kt + d * 64 + i0) = o;
    }
  }
  {
    const int c = tid;
    const bool isu = c < 128;
    const char* src = isu ? (vs + c * 2) : (ks + (c - 128) * 2);
    float x[64];
#pragma unroll
    for (int i = 0; i < 64; ++i) x[i] = 0.f;
    int zero;
    asm volatile("v_mov_b32 %0, 0" : "=v"(zero));
#pragma unroll
    for (int i = 0; i < 64; ++i) {
      const float* amz = am + zero;
      const float* sbz = sbeta + zero;
      const float eg = __expf(sbz[64 + i]);
      float acc = bf2f(*(const unsigned short*)(src + i * 272)) * sbz[i] * (isu ? 1.0f : eg);
#pragma unroll
      for (int j4 = 0; j4 < (i + 3) / 4; ++j4) {
        const f32x4 a = *(const f32x4*)(amz + i * 68 + j4 * 4);
        acc -= a[0] * x[j4 * 4 + 0];
        acc -= a[1] * x[j4 * 4 + 1];
        acc -= a[2] * x[j4 * 4 + 2];
        acc -= a[3] * x[j4 * 4 + 3];
      }
      asm volatile("" : "+v"(zero), "+v"(acc));
      x[i] = acc;
    }
    bf16_t* dst = r1 + (isu ? 2048 : 1024) + h * 128 + (c & 127);
#pragma unroll
    for (int i = 0; i < 64; ++i) {
      const int t = t0 + i;
      if (t >= 0) dst[(size_t)t * 3072] = f2bf(x[i]);
    }
  }
  __syncthreads();
}

constexpr int NW = 2;
DEVI void scan_item(const Params& p, int h, int sl, char* smem) {
  const int tid = TIDX, lane = tid & 63, wave = tid >> 6, l15 = lane & 15, quad = lane >> 4;
  bf16_t* r1 = (bf16_t*)(p.ws + OFF_R1);
  const bf16_t* r0 = (const bf16_t*)(p.ws + OFF_R0);
  char* wsm = smem;
  char* qksm = smem + 17408;
  char* ktsm = smem + 26624;
  char* usm = smem + 45056;
  float* gsm = (float*)(smem + 50176);
  char* sbx = smem + 51200;
  char* vbx = smem + 59392;
  constexpr int USTR = (NW * 16 + 8) * 2;
  const int vb0 = sl * NW * 16;
  const bool is_state = wave < NW;
  const int cw = is_state ? wave : wave - NW;
  u32x4 pw[4], pqk[2], pkt[4], pg = u32x4{0, 0, 0, 0}, pu = u32x4{0, 0, 0, 0};
  auto gload = [&](int n) {
    const int t0 = n * 64 - 48;
#pragma unroll
    for (int i = 0; i < 4; ++i) {
      const int ch = tid + i * 256, row = ch >> 4, kc = ch & 15;
      const int t = t0 + row;
      pw[i] = u32x4{0, 0, 0, 0};
      if (t >= 0) pw[i] = *(const u32x4*)(r1 + (size_t)t * 3072 + 1024 + h * 128 + kc * 8);
    }
    const bf16_t* qk = r0 + R0_QK + (size_t)(n * 8 + h) * 4096;
#pragma unroll
    for (int i = 0; i < 2; ++i) pqk[i] = *(const u32x4*)(qk + (size_t)(tid + i * 256) * 8);
    const bf16_t* kt = r0 + R0_KT + (size_t)(n * 8 + h) * 8192;
#pragma unroll
    for (int i = 0; i < 4; ++i) pkt[i] = *(const u32x4*)(kt + (size_t)(tid + i * 256) * 8);
    if (tid < 48) pg = *(const u32x4*)((const float*)(r0 + R0_G) + (size_t)(n * 8 + h) * 192 + tid * 4);
    if (tid < 64 * NW * 2) {
      const int row = tid / (NW * 2), kc = tid % (NW * 2);
      const int t = t0 + row;
      pu = u32x4{0, 0, 0, 0};
      if (t >= 0) pu = *(const u32x4*)(r1 + (size_t)t * 3072 + 2048 + h * 128 + vb0 + kc * 8);
    }
  };
  auto lstore = [&]() {
#pragma unroll
    for (int i = 0; i < 4; ++i) {
      const int ch = tid + i * 256, row = ch >> 4, kc = ch & 15;
      *(u32x4*)(wsm + row * 272 + kc * 16) = pw[i];
    }
    if (tid < 48) *(u32x4*)(gsm + tid * 4) = pg;
    if (tid < 64 * NW * 2) {
      const int row = tid / (NW * 2), kc = tid % (NW * 2);
      *(u32x4*)(usm + row * USTR + kc * 16) = pu;
    }
  };
  auto lstore2 = [&]() {
#pragma unroll
    for (int i = 0; i < 2; ++i) {
      const int ch = tid + i * 256, row = ch >> 3, kc = ch & 7;
      *(u32x4*)(qksm + row * 144 + kc * 16) = pqk[i];
    }
#pragma unroll
    for (int i = 0; i < 4; ++i) {
      const int ch = tid + i * 256, row = ch >> 3, kc = ch & 7;
      *(u32x4*)(ktsm + row * 144 + kc * 16) = pkt[i];
    }
  };
  bf16x8 qfr[2][4];
  auto qload = [&](int n) {
    const int t0 = n * 64 - 48;
#pragma unroll
    for (int mt = 0; mt < 2; ++mt) {
      const int t = t0 + (cw * 2 + mt) * 16 + l15;
#pragma unroll
      for (int s = 0; s < 4; ++s) {
        u32x4 v4 = u32x4{0, 0, 0, 0};
        if (t >= 0) v4 = *(const u32x4*)(r1 + (size_t)t * 3072 + h * 128 + s * 32 + quad * 8);
        qfr[mt][s] = __builtin_bit_cast(bf16x8, v4);
      }
    }
  };
  f32x4 S[8];
#pragma unroll
  for (int r = 0; r < 8; ++r) S[r] = f32x4{0.f, 0.f, 0.f, 0.f};
  gload(0);
  if (!is_state) qload(0);
  for (int n = 0; n < NCH; ++n) {
    lstore();
    if (is_state) {
#pragma unroll
      for (int s = 0; s < 4; ++s) *(bf16x8*)(sbx + ((cw * 4 + s) * 64 + lane) * 16) = pack8(S[2 * s], S[2 * s + 1]);
    }
    __syncthreads();
    lstore2();
    if (n + 1 < NCH) gload(n + 1);
    if (is_state) {
      bf16x8 sb[4];
#pragma unroll
      for (int s = 0; s < 4; ++s) sb[s] = pack8(S[2 * s], S[2 * s + 1]);
      f32x4 vnew[4];
#pragma unroll
      for (int mt = 0; mt < 4; ++mt) vnew[mt] = f32x4{0.f, 0.f, 0.f, 0.f};
#pragma unroll
      for (int s = 0; s < 4; ++s) {
#pragma unroll
        for (int mt = 0; mt < 4; ++mt) {
          const char* aw = wsm + (mt * 16 + l15) * 272 + s * 64 + quad * 8;
          bf16x8 wf = mk8(*(const u32x2*)aw, *(const u32x2*)(aw + 32));
          vnew[mt] = MFMA16(wf, sb[s], vnew[mt]);
        }
      }
#pragma unroll
      for (int mt = 0; mt < 4; ++mt) {
#pragma unroll
        for (int jj = 0; jj < 4; ++jj) {
          const int cidx = mt * 16 + quad * 4 + jj;
          const float u = bf2f(*(const unsigned short*)(usm + cidx * USTR + (cw * 16 + l15) * 2));
          vnew[mt][jj] = u - vnew[mt][jj];
        }
      }
#pragma unroll
      for (int s2 = 0; s2 < 2; ++s2)
        *(bf16x8*)(vbx + ((cw * 2 + s2) * 64 + lane) * 16) = pack8(vnew[2 * s2], vnew[2 * s2 + 1]);
      __syncthreads();
      const float eglast = gsm[128];
      bf16x8 vb[2];
#pragma unroll
      for (int mt = 0; mt < 4; ++mt) {
        const f32x4 gd4 = *(const f32x4*)(gsm + 64 + mt * 16 + quad * 4);
        vnew[mt] = vnew[mt] * gd4;
      }
#pragma unroll
      for (int s2 = 0; s2 < 2; ++s2) vb[s2] = pack8(vnew[2 * s2], vnew[2 * s2 + 1]);
#pragma unroll
      for (int r = 0; r < 8; ++r) S[r] = S[r] * eglast;
#pragma unroll
      for (int s2 = 0; s2 < 2; ++s2) {
#pragma unroll
        for (int r = 0; r < 8; ++r) {
          const char* ap = ktsm + (r * 16 + l15) * 144 + s2 * 64 + quad * 8;
          bf16x8 f = mk8(*(const u32x2*)ap, *(const u32x2*)(ap + 32));
          S[r] = MFMA16(f, vb[s2], S[r]);
        }
      }
    } else {
      f32x4 acco[2][NW];
#pragma unroll
      for (int ct = 0; ct < NW; ++ct) {
        bf16x8 sb[4];
#pragma unroll
        for (int s = 0; s < 4; ++s) sb[s] = *(const bf16x8*)(sbx + ((ct * 4 + s) * 64 + lane) * 16);
#pragma unroll
        for (int m = 0; m < 2; ++m) acco[m][ct] = f32x4{0.f, 0.f, 0.f, 0.f};
#pragma unroll
        for (int s = 0; s < 4; ++s)
#pragma unroll
          for (int m = 0; m < 2; ++m) acco[m][ct] = MFMA16(qfr[m][s], sb[s], acco[m][ct]);
      }
      if (n + 1 < NCH) qload(n + 1);
      __syncthreads();
      const int t0 = n * 64 - 48;
#pragma unroll
      for (int m = 0; m < 2; ++m) {
        const int mt = cw * 2 + m;
        bf16x8 qkf[2];
#pragma unroll
        for (int s2 = 0; s2 < 2; ++s2) {
          const char* a = qksm + (mt * 16 + l15) * 144 + s2 * 64 + quad * 8;
          qkf[s2] = mk8(*(const u32x2*)a, *(const u32x2*)(a + 32));
        }
        const f32x4 ge4 = *(const f32x4*)(gsm + mt * 16 + quad * 4);
#pragma unroll
        for (int ct = 0; ct < NW; ++ct) {
          f32x4 a2 = f32x4{0.f, 0.f, 0.f, 0.f};
#pragma unroll
          for (int s2 = 0; s2 < 2; ++s2) {
            const bf16x8 vb = *(const bf16x8*)(vbx + ((ct * 2 + s2) * 64 + lane) * 16);
            a2 = MFMA16(qkf[s2], vb, a2);
          }
#pragma unroll
          for (int jj = 0; jj < 4; ++jj) {
            const int t = t0 + mt * 16 + quad * 4 + jj;
            const float o = ge4[jj] * acco[m][ct][jj] + a2[jj];
            if (t >= 0) r1[(size_t)t * 3072 + 2048 + h * 128 + vb0 + ct * 16 + l15] = f2bf(o);
          }
        }
      }
    }
    __syncthreads();
  }
}

DEVI void gate_phase(const Params& p, int j) {
  bf16_t* r1 = (bf16_t*)(p.ws + OFF_R1);
  const bf16_t* z = (const bf16_t*)(p.ws + OFF_R0) + R0_Z;
  const float* nw = p.in[13] + j * 128;
  const int tid = TIDX;
  const int lane = tid & 63;
  const int gw = BIDX * 4 + (tid >> 6), nwv = gridDim.x * 4;
  const int half = lane >> 5, l31 = lane & 31;
  const f32x4 w = *(const f32x4*)(nw + l31 * 4);
  for (int t = gw; t < L; t += nwv) {
    u32x2 ov[4], zv[4];
#pragma unroll
    for (int q = 0; q < 4; ++q) {
      const int h = q * 2 + half;
      ov[q] = *(const u32x2*)(r1 + (size_t)t * 3072 + 2048 + h * 128 + l31 * 4);
      zv[q] = *(const u32x2*)(z + (size_t)t * 1024 + h * 128 + l31 * 4);
    }
    float ss[4];
#pragma unroll
    for (int q = 0; q < 4; ++q) {
      const float o0 = bflo(ov[q].x), o1 = bfhi(ov[q].x), o2 = bflo(ov[q].y), o3 = bfhi(ov[q].y);
      ss[q] = o0 * o0 + o1 * o1 + o2 * o2 + o3 * o3;
    }
#pragma unroll
    for (int m = 16; m >= 1; m >>= 1) {
#pragma unroll
      for (int q = 0; q < 4; ++q) ss[q] += __shfl_xor(ss[q], m);
    }
#pragma unroll
    for (int q = 0; q < 4; ++q) {
      const int h = q * 2 + half;
      const float r = rsqrtf(ss[q] * (1.f / 128.f) + 1e-6f);
      const float o[4] = {bflo(ov[q].x), bfhi(ov[q].x), bflo(ov[q].y), bfhi(ov[q].y)};
      const float zz[4] = {bflo(zv[q].x), bfhi(zv[q].x), bflo(zv[q].y), bfhi(zv[q].y)};
      float y[4];
#pragma unroll
      for (int e = 0; e < 4; ++e) y[e] = o[e] * r * w[e] * (zz[e] / (1.f + __expf(-zz[e])));
      *(u32x2*)(r1 + (size_t)t * 3072 + h * 128 + l31 * 4) = u32x2{pack2(y[0], y[1]), pack2(y[2], y[3])};
    }
  }
}


#define XB_TMO      128
#define XB_XCNT(j)  (256  + 64 * (j))
#define XB_XSUB(j)  (1280 + 64 * (j))
#define XB_XGEN(j)  (2304 + 64 * (j))
#define XB_TOP      3328
#define XB_TOPGEN   3392
#define XCD_BAR_WORDS 3456
#define XB_SPIN_CAP (1u << 20)
#define LAS __attribute__((address_space(3)))
DEVI unsigned xb_ld(unsigned* p) { return __hip_atomic_load(p, __ATOMIC_RELAXED, __HIP_MEMORY_SCOPE_AGENT); }
DEVI unsigned xb_add(unsigned* p, unsigned v) { return __hip_atomic_fetch_add(p, v, __ATOMIC_RELAXED, __HIP_MEMORY_SCOPE_AGENT); }
#define XB_SPIN(cond, bar) do { unsigned _sp = 0; while (cond) { __builtin_amdgcn_s_sleep(24); \
    if ((++_sp & 255u) == 0u) { if (xb_ld(&(bar)[XB_TMO])) break; if (_sp > XB_SPIN_CAP) { atomicAdd(&(bar)[XB_TMO], 1u); break; } } } } while (0)
struct XcdBarrier {
  unsigned* bar; unsigned x;
  volatile LAS unsigned* st;
};
DEVI XcdBarrier xcd_barrier_post(unsigned* bar, volatile LAS unsigned* st) {
  XcdBarrier b; b.bar = bar; b.x = xb_xcc_id(); b.st = st;
  if (threadIdx.x == 0) (void)xb_add(&bar[XB_XCNT(b.x)], 1u);
  return b;
}
DEVI void xcd_barrier_complete(unsigned* bar, unsigned x, unsigned& nloc, unsigned& nx) {
  const unsigned G = gridDim.x * gridDim.y * gridDim.z;
  unsigned sum, cnt, mine, sp = 0u;
  for (;;) {
    sum = 0u; cnt = 0u; mine = 0u;
#pragma unroll
    for (unsigned j = 0; j < 16; ++j) { const unsigned c = xb_ld(&bar[XB_XCNT(j)]); sum += c; cnt += (c > 0u) ? 1u : 0u; mine = (j == x) ? c : mine; }
    if (sum == G) break;
    __builtin_amdgcn_s_sleep(1);
    if ((++sp & 255u) == 0u) { if (xb_ld(&bar[XB_TMO])) break; if (sp > XB_SPIN_CAP) { atomicAdd(&bar[XB_TMO], 1u); break; } }
  }
  nloc = mine > 0u ? mine : 1u; nx = cnt > 0u ? cnt : 1u;
}
DEVI void xcd_barrier(const XcdBarrier& b) {
  asm volatile("s_waitcnt vmcnt(0)" ::: "memory");
  __syncthreads();
  if (threadIdx.x == 0) {
    unsigned* bar = b.bar;
    __builtin_amdgcn_s_waitcnt(0);
    unsigned nloc = b.st[0], nx = b.st[1];
    if (nloc == 0u) { xcd_barrier_complete(bar, b.x, nloc, nx); b.st[0] = nloc; b.st[1] = nx; }
    const unsigned old = xb_add(&bar[XB_XSUB(b.x)], 1u);
    const unsigned gen = old / nloc;
    if (old + 1u == (gen + 1u) * nloc) {
      __builtin_amdgcn_fence(__ATOMIC_RELEASE, "agent");
      asm volatile("s_waitcnt vmcnt(0)" ::: "memory");
      const unsigned og = xb_add(&bar[XB_TOP], 1u);
      const unsigned tg = og / nx;
      if (og + 1u == (tg + 1u) * nx) xb_add(&bar[XB_TOPGEN], 1u);
      else XB_SPIN(xb_ld(&bar[XB_TOPGEN]) == tg, bar);
      __builtin_amdgcn_fence(__ATOMIC_ACQUIRE, "agent");
      xb_add(&bar[XB_XGEN(b.x)], 1u);
      asm volatile("s_waitcnt vmcnt(0)" ::: "memory");
    } else {
      XB_SPIN(xb_ld(&bar[XB_XGEN(b.x)]) == gen, bar);
      __builtin_amdgcn_fence(__ATOMIC_ACQUIRE, "agent");
      asm volatile("s_waitcnt vmcnt(0)" ::: "memory");
    }
  }
  __syncthreads();
}

#ifndef ENABLE
#define ENABLE 0xFFFF
#endif
#define EN(bit) if constexpr ((ENABLE >> (bit)) & 1)
__global__ void __launch_bounds__(256, 2) mk(Params p_in, int ph_lo, int ph_hi) {
  extern __shared__ __attribute__((aligned(16))) char smem[];
  __shared__ uint4 sh_misc[2];
  int& s_item = *(int*)&sh_misc[1];
  cg::grid_group grid = cg::this_grid();
  if (threadIdx.x == 0) sh_misc[0] = make_uint4(0u, 0u, 0u, 0u);
  __syncthreads();
  const XcdBarrier xb = xcd_barrier_post((unsigned*)(p_in.ws + OFF_BAR), (volatile LAS unsigned*)&sh_misc[0]);
  grid.sync();
  for (int ph = ph_lo; ph < ph_hi; ++ph) {
    long zoff = 0;
    asm volatile("" : "+s"(zoff));
    Params p;
#pragma unroll
    for (int i = 0; i < 21; ++i) p.in[i] = (const float*)((GLOBAL_AS const float*)(p_in.in[i]));
    p.ws = (char*)((GLOBAL_AS char*)(p_in.ws + zoff));
    p.out = (float*)((GLOBAL_AS float*)(p_in.out + zoff));
    bf16_t* hb = (bf16_t*)(p.ws + OFF_HB);
    bf16_t* wb = (bf16_t*)(p.ws + OFF_WB);
    bf16_t* r0 = (bf16_t*)(p.ws + OFF_R0);
    bf16_t* r1 = (bf16_t*)(p.ws + OFF_R1);
    if (ph == 0) {
      EN(0) { init_phase(p); }
      EN(1) { convert_layer(p, 0, smem); }
    } else {
      const int layer = (ph - 1) / 10, sub = (ph - 1) % 10;
      const int j = layer >> 1;
      const bool even = (layer & 1) == 0;
      if (even && sub >= 3 && sub <= 5) continue;
      if (even) {
        if (sub == 0) {
          EN(2) { gemm_phase(hb, 1024, wb + WB_IN, 1024, 16, smem, EpiEvenIn{r0}); }
        } else if (sub == 1) {
          EN(3) { pool_phase(p); }
          const float linit = 0.8f - 0.6f * expf(-0.3f * (float)layer);
          EN(4) { attn_phase(p, j, linit, smem, &s_item); }
        } else if (sub == 2) {
          EN(2) { gemm_phase(r1, 1024, wb + WB_OUT, 1024, 8, smem, EpiResid{p}); }
        }
      } else {
        if (sub == 0) {
          EN(2) { gemm_phase(hb, 1024, wb + WB_IN, 1024, 25, smem, EpiOddIn{r0, (float*)(p.ws + OFF_BA)}); }
        } else if (sub == 1) {
          EN(5) { conv_phase(p, j); }
        } else if (sub == 2) {
          EN(6) { for (int it = BIDX; it < NCH * 8; it += gridDim.x) prep_item(p, j, it >> 3, it & 7, smem); }
        } else if (sub == 3) {
          const int nitems = 8 * (8 / NW);
          if ((int)BIDX < nitems) {
            EN(7) { scan_item(p, BIDX / (8 / NW), BIDX % (8 / NW), smem); }
          } else {
            EN(2) { gemm_phase(hb, 1024, wb + WB_Z, 1024, 8, smem, EpiZ{r0 + R0_Z}, nitems); }
          }
        } else if (sub == 4) {
          EN(8) { gate_phase(p, j); }
        } else if (sub == 5) {
          EN(2) { gemm_phase(r1, 3072, wb + WB_OUT, 1024, 8, smem, EpiResid{p}); }
        }
      }
      if (sub == 6) {
        EN(9) { ln_phase(p, p.in[17] + layer * 1024, p.in[18] + layer * 1024); }
      } else if (sub == 7) {
        EN(2) { gemm_phase(hb, 1024, wb + WB_W1, 1024, 32, smem, EpiSqRelu{r0}); }
      } else if (sub == 8) {
        EN(2) { gemm_phase(r0, 4096, wb + WB_W2, 4096, 8, smem, EpiResid{p}); }
      } else if (sub == 9) {
        EN(9) { ln_phase(p, p.in[19] + layer * 1024, p.in[20] + layer * 1024); }
        EN(1) { if (layer < 3) convert_layer(p, layer + 1, smem); }
      }
    }
    if (ph + 1 < ph_hi) xcd_barrier(xb);
  }
}

extern "C" void kernel_launch(void* const* d_in, const int* in_sizes, int n_in, void* d_out, int out_size,
                              void* d_ws, size_t ws_size, hipStream_t stream) {
  static int grid_blocks = 0;
  if (!grid_blocks) {
    int dev = 0, cus = 0, per_cu = 0;
    (void)hipGetDevice(&dev);
    (void)hipDeviceGetAttribute(&cus, hipDeviceAttributeMultiprocessorCount, dev);
    (void)hipFuncSetAttribute((const void*)mk, hipFuncAttributeMaxDynamicSharedMemorySize, SMEM_BYTES);
    (void)hipOccupancyMaxActiveBlocksPerMultiprocessor(&per_cu, mk, 256, SMEM_BYTES);
    if (per_cu > 2) per_cu = 2;
    if (per_cu < 1) per_cu = 1;
    grid_blocks = cus * per_cu;
  }
  Params p{};
  for (int i = 0; i < 21; ++i) p.in[i] = (const float*)d_in[i];
  p.out = (float*)d_out;
  p.ws = (char*)d_ws;
  int lo = 0, hi = 41;
  void* args[] = {&p, &lo, &hi};
  (void)hipMemsetAsync((char*)d_ws + OFF_BAR, 0, 16384, stream);
  (void)hipLaunchCooperativeKernel((void*)mk, dim3(grid_blocks), dim3(256), args, SMEM_BYTES, stream);
}
```

```cpp
#include <hip/hip_runtime.h>
#include <hip/hip_cooperative_groups.h>
namespace cg = cooperative_groups;

typedef unsigned short bf16_t;
using bf16x8 = __attribute__((ext_vector_type(8))) short;
using f32x4 = __attribute__((ext_vector_type(4))) float;
using u32x4 = __attribute__((ext_vector_type(4))) unsigned;
using u32x2 = __attribute__((ext_vector_type(2))) unsigned;
typedef __bf16 bf2_t __attribute__((ext_vector_type(2)));
typedef float f2_t __attribute__((ext_vector_type(2)));

#define DEVI __device__ __forceinline__
#define GLOBAL_AS __attribute__((address_space(1)))

DEVI unsigned xb_xcc_id() { return (unsigned)__builtin_amdgcn_s_getreg((3 << 11) | 20) & 0xFu; }
DEVI int opaque_tid() { int t = threadIdx.x; asm volatile("" : "+v"(t)); return t; }
DEVI int opaque_bid() { int b = blockIdx.x; asm volatile("" : "+s"(b)); return b; }
#define TIDX opaque_tid()
#define BIDX opaque_bid()

constexpr int L = 16400;
constexpr int LR = 16512;
constexpr int NMT = 129;
constexpr int NCH = 257;
constexpr float ALPHA = 1.6817928305074290f;
constexpr float LOG2E = 1.4426950408889634f;

constexpr size_t OFF_HB = 0;
constexpr size_t OFF_WB = 33816576;
constexpr size_t OFF_METAH = 61341696;
constexpr size_t OFF_MISC = 61407232;
constexpr size_t OFF_BA = 61411328;
constexpr size_t OFF_R0 = 62468096;
constexpr size_t OFF_R1 = 163917824;
constexpr size_t OFF_BAR = 265367552;
constexpr size_t WB_IN = 0, WB_Z = 3276800, WB_OUT = 4325376, WB_W1 = 5373952, WB_W2 = 9568256;
constexpr size_t R0_Q = 0, R0_K = 8454144, R0_VT = 16908288, R0_U = 25362432;
constexpr size_t R0_KT = 0, R0_QK = 16842752, R0_G = 25264128, R0_Z = 26100000;

constexpr int SMEM_BYTES = 73728 + 1024;

struct Params {
  const float* in[21];
  float* out;
  char* ws;
};

DEVI unsigned pack2(float a, float b) {
  f2_t v = {a, b};
  bf2_t r = __builtin_convertvector(v, bf2_t);
  return __builtin_bit_cast(unsigned, r);
}
DEVI bf16_t f2bf(float a) { return (bf16_t)(pack2(a, 0.f) & 0xffff); }
DEVI float bf2f(bf16_t b) { return __uint_as_float(((unsigned)b) << 16); }
DEVI float bflo(unsigned u) { return __uint_as_float(u << 16); }
DEVI float bfhi(unsigned u) { return __uint_as_float(u & 0xffff0000u); }

DEVI float* hfrow(const Params& p, int t) {
  return t < 16 ? (float*)(p.ws + OFF_METAH) + t * 1024 : p.out + (size_t)(t - 16) * 1024;
}
DEVI float wave_sum(float v) {
#pragma unroll
  for (int m = 32; m >= 1; m >>= 1) v += __shfl_xor(v, m);
  return v;
}
DEVI bf16x8 mk8(u32x2 a, u32x2 b) {
  u32x4 r = {a.x, a.y, b.x, b.y};
  return __builtin_bit_cast(bf16x8, r);
}
DEVI bf16x8 pack8(f32x4 a, f32x4 b) {
  u32x4 r = {pack2(a[0], a[1]), pack2(a[2], a[3]), pack2(b[0], b[1]), pack2(b[2], b[3])};
  return __builtin_bit_cast(bf16x8, r);
}
DEVI size_t wfm(int n, int k, int K) {
  return ((size_t)(n >> 4) * (K >> 5) + (k >> 5)) * 512 + ((((k >> 3) & 3) << 4) + (n & 15)) * 8 + (k & 7);
}
#define MFMA16(a, b, c) __builtin_amdgcn_mfma_f32_16x16x32_bf16((a), (b), (c), 0, 0, 0)

template <class Epi>
DEVI void gemm_tile(const bf16_t* __restrict__ A, int lda, const bf16_t* __restrict__ Bt, int K,
                    int m0, int n0, char* smem, Epi epi) {
  const int tid = TIDX, lane = tid & 63, wave = tid >> 6;
  const int wm = wave >> 1, wn = wave & 1, l15 = lane & 15, quad = lane >> 4;
  f32x4 acc[4][4];
#pragma unroll
  for (int i = 0; i < 4; ++i)
#pragma unroll
    for (int j = 0; j < 4; ++j) acc[i][j] = f32x4{0.f, 0.f, 0.f, 0.f};
  const int lrow = tid >> 3, lkc = tid & 7;
  const bf16_t* ag = A + (size_t)(m0 + lrow) * lda + lkc * 8;
  const bf16_t* bg = Bt + (size_t)(n0 + lrow) * K + lkc * 8;
  u32x4 ra[4], rb[4];
#pragma unroll
  for (int i = 0; i < 4; ++i) {
    ra[i] = *(const u32x4*)(ag + (size_t)(i * 32) * lda);
    rb[i] = *(const u32x4*)(bg + (size_t)(i * 32) * K);
  }
  const int lds_w = lrow * 128 + ((lkc ^ (lrow & 7)) << 4);
#pragma unroll
  for (int i = 0; i < 4; ++i) {
    *(u32x4*)(smem + lds_w + i * 4096) = ra[i];
    *(u32x4*)(smem + 16384 + lds_w + i * 4096) = rb[i];
  }
  __syncthreads();
  const int nk = K >> 6;
  const int sw = (quad ^ (l15 & 7)) << 4;
  const int a_rd = (wm * 64 + l15) * 128 + sw;
  const int b_rd = 16384 + (wn * 64 + l15) * 128 + sw;
  for (int kt = 0; kt < nk; ++kt) {
    const int buf = (kt & 1) * 32768;
    if (kt + 1 < nk) {
#pragma unroll
      for (int i = 0; i < 4; ++i) {
        ra[i] = *(const u32x4*)(ag + (size_t)(i * 32) * lda + (kt + 1) * 64);
        rb[i] = *(const u32x4*)(bg + (size_t)(i * 32) * K + (kt + 1) * 64);
      }
    }
#pragma unroll
    for (int ks = 0; ks < 2; ++ks) {
      bf16x8 af[4], bf[4];
#pragma unroll
      for (int i = 0; i < 4; ++i) {
        af[i] = *(const bf16x8*)(smem + buf + ((a_rd + i * 2048) ^ (ks * 64)));
        bf[i] = *(const bf16x8*)(smem + buf + ((b_rd + i * 2048) ^ (ks * 64)));
      }
#pragma unroll
      for (int mi = 0; mi < 4; ++mi)
#pragma unroll
        for (int ni = 0; ni < 4; ++ni) acc[mi][ni] = MFMA16(bf[ni], af[mi], acc[mi][ni]);
    }
    if (kt + 1 < nk) {
      const int nb = ((kt + 1) & 1) * 32768;
#pragma unroll
      for (int i = 0; i < 4; ++i) {
        *(u32x4*)(smem + nb + lds_w + i * 4096) = ra[i];
        *(u32x4*)(smem + nb + 16384 + lds_w + i * 4096) = rb[i];
      }
    }
    __syncthreads();
  }
#pragma unroll
  for (int mi = 0; mi < 4; ++mi)
#pragma unroll
    for (int ni = 0; ni < 4; ++ni)
      epi(m0 + wm * 64 + mi * 16 + l15, n0 + wn * 64 + ni * 16 + quad * 4, acc[mi][ni]);
}

template <class Epi>
DEVI void gemm_tile256(const bf16_t* __restrict__ A, int lda, const bf16_t* __restrict__ Bt, int K,
                       int m0, int n0, char* smem, Epi epi) {
  const int tid = TIDX, lane = tid & 63, wave = tid >> 6;
  const int wm = wave >> 1, wn = wave & 1, l15 = lane & 15, quad = lane >> 4;
  f32x4 acc[8][4];
#pragma unroll
  for (int i = 0; i < 8; ++i)
#pragma unroll
    for (int j = 0; j < 4; ++j) acc[i][j] = f32x4{0.f, 0.f, 0.f, 0.f};
  const int lrow = tid >> 3, lkc = tid & 7;
  const bf16_t* ag = A + (size_t)(m0 + lrow) * lda + lkc * 8;
  const bf16_t* bg = Bt + (size_t)(n0 + lrow) * K + lkc * 8;
  u32x4 ra[8], rb[4];
  auto gload = [&](int kt) {
#pragma unroll
    for (int i = 0; i < 8; ++i) ra[i] = *(const u32x4*)(ag + (size_t)(i * 32) * lda + kt * 64);
#pragma unroll
    for (int i = 0; i < 4; ++i) rb[i] = *(const u32x4*)(bg + (size_t)(i * 32) * K + kt * 64);
  };
  const int lds_w = lrow * 128 + ((lkc ^ (lrow & 7)) << 4);
  const int nk = K >> 6;
  const int sw = (quad ^ (l15 & 7)) << 4;
  const int a_rd = (wm * 128 + l15) * 128 + sw;
  const int b_rd = 32768 + (wn * 64 + l15) * 128 + sw;
  gload(0);
  for (int kt = 0; kt < nk; ++kt) {
#pragma unroll
    for (int i = 0; i < 8; ++i) *(u32x4*)(smem + lds_w + i * 4096) = ra[i];
#pragma unroll
    for (int i = 0; i < 4; ++i) *(u32x4*)(smem + 32768 + lds_w + i * 4096) = rb[i];
    __syncthreads();
    if (kt + 1 < nk) gload(kt + 1);
#pragma unroll
    for (int ks = 0; ks < 2; ++ks) {
      bf16x8 af[8], bf[4];
#pragma unroll
      for (int i = 0; i < 4; ++i) bf[i] = *(const bf16x8*)(smem + ((b_rd + i * 2048) ^ (ks * 64)));
#pragma unroll
      for (int i = 0; i < 8; ++i) af[i] = *(const bf16x8*)(smem + ((a_rd + i * 2048) ^ (ks * 64)));
#pragma unroll
      for (int mi = 0; mi < 8; ++mi)
#pragma unroll
        for (int ni = 0; ni < 4; ++ni) acc[mi][ni] = MFMA16(bf[ni], af[mi], acc[mi][ni]);
    }
    __syncthreads();
  }
#pragma unroll
  for (int mi = 0; mi < 8; ++mi)
#pragma unroll
    for (int ni = 0; ni < 4; ++ni)
      epi(m0 + wm * 128 + mi * 16 + l15, n0 + wn * 64 + ni * 16 + quad * 4, acc[mi][ni]);
}

template <class Epi>
DEVI void gemm_tile256b(const bf16_t* __restrict__ A, int lda, const bf16_t* __restrict__ Bt, int K,
                        int m0, int n0, char* smem, Epi epi) {
  const int tid = TIDX, lane = tid & 63, wave = tid >> 6;
  const int wm = wave >> 1, wn = wave & 1, l15 = lane & 15, quad = lane >> 4;
  f32x4 acc[8][4];
#pragma unroll
  for (int i = 0; i < 8; ++i)
#pragma unroll
    for (int j = 0; j < 4; ++j) acc[i][j] = f32x4{0.f, 0.f, 0.f, 0.f};
  const int lrow = tid >> 3, lkc = tid & 7;
  const bf16_t* ag = A + (size_t)(m0 + lrow) * lda + lkc * 8;
  const int kb32 = K >> 5;
  const bf16_t* bp = Bt + ((size_t)((n0 + wn * 64) >> 4) * kb32) * 512 + lane * 8;
  u32x4 ra[8];
  bf16x8 b0[4], b1[4];
  const int lds_w = lrow * 128 + ((lkc ^ (lrow & 7)) << 4);
  const int nk = K >> 6;
  const int sw = (quad ^ (l15 & 7)) << 4;
  const int a_rd = (wm * 128 + l15) * 128 + sw;
#pragma unroll
  for (int i = 0; i < 8; ++i) ra[i] = *(const u32x4*)(ag + (size_t)(i * 32) * lda);
#pragma unroll
  for (int i = 0; i < 4; ++i) b0[i] = *(const bf16x8*)(bp + ((size_t)i * kb32) * 512);
#pragma unroll
  for (int i = 0; i < 8; ++i) *(u32x4*)(smem + lds_w + i * 4096) = ra[i];
  __syncthreads();
  for (int kt = 0; kt < nk; ++kt) {
    const char* base = smem + (kt & 1) * 32768;
    const bool more = kt + 1 < nk;
    if (more) {
#pragma unroll
      for (int i = 0; i < 8; ++i) ra[i] = *(const u32x4*)(ag + (size_t)(i * 32) * lda + (kt + 1) * 64);
    }
#pragma unroll
    for (int i = 0; i < 4; ++i) b1[i] = *(const bf16x8*)(bp + ((size_t)i * kb32 + kt * 2 + 1) * 512);
    {
      bf16x8 af[8];
#pragma unroll
      for (int i = 0; i < 8; ++i) af[i] = *(const bf16x8*)(base + a_rd + i * 2048);
#pragma unroll
      for (int mi = 0; mi < 8; ++mi)
#pragma unroll
        for (int ni = 0; ni < 4; ++ni) acc[mi][ni] = MFMA16(b0[ni], af[mi], acc[mi][ni]);
    }
    if (more) {
#pragma unroll
      for (int i = 0; i < 4; ++i) b0[i] = *(const bf16x8*)(bp + ((size_t)i * kb32 + kt * 2 + 2) * 512);
    }
    {
      bf16x8 af[8];
#pragma unroll
      for (int i = 0; i < 8; ++i) af[i] = *(const bf16x8*)(base + ((a_rd + i * 2048) ^ 64));
#pragma unroll
      for (int mi = 0; mi < 8; ++mi)
#pragma unroll
        for (int ni = 0; ni < 4; ++ni) acc[mi][ni] = MFMA16(b1[ni], af[mi], acc[mi][ni]);
    }
    if (more) {
      char* nb = smem + ((kt + 1) & 1) * 32768 + lds_w;
#pragma unroll
      for (int i = 0; i < 8; ++i) *(u32x4*)(nb + i * 4096) = ra[i];
    }
    __syncthreads();
  }
#pragma unroll
  for (int mi = 0; mi < 8; ++mi)
#pragma unroll
    for (int ni = 0; ni < 4; ++ni)
      epi(m0 + wm * 128 + mi * 16 + l15, n0 + wn * 64 + ni * 16 + quad * 4, acc[mi][ni]);
}

template <class Epi>
DEVI void gemm_tail_tile(const bf16_t* __restrict__ A, int lda, const bf16_t* __restrict__ Bt, int K, int n0,
                         char* smem, Epi epi) {
  const int tid = TIDX, lane = tid & 63, wave = tid >> 6, l15 = lane & 15, quad = lane >> 4;
  constexpr int M0 = 16384;
  f32x4 acc[8];
#pragma unroll
  for (int i = 0; i < 8; ++i) acc[i] = f32x4{0.f, 0.f, 0.f, 0.f};
  const int kq = K >> 2;
  const bf16_t* ag = A + (size_t)(M0 + l15) * lda + wave * kq + quad * 8;
  const int kb32 = K >> 5;
  const bf16_t* bg = Bt + ((size_t)(n0 >> 4) * kb32 + ((wave * kq) >> 5)) * 512 + lane * 8;
  bf16x8 a0, a1, b0[8], b1[8];
  auto tload = [&](bf16x8& a, bf16x8 (&b)[8], int k) {
    a = *(const bf16x8*)(ag + k);
#pragma unroll
    for (int nt = 0; nt < 8; ++nt) b[nt] = *(const bf16x8*)(bg + ((size_t)nt * kb32 + (k >> 5)) * 512);
  };
  tload(a0, b0, 0);
  tload(a1, b1, 32);
  for (int k = 0; k < kq; k += 64) {
#pragma unroll
    for (int nt = 0; nt < 8; ++nt) acc[nt] = MFMA16(b0[nt], a0, acc[nt]);
    if (k + 64 < kq) tload(a0, b0, k + 64);
#pragma unroll
    for (int nt = 0; nt < 8; ++nt) acc[nt] = MFMA16(b1[nt], a1, acc[nt]);
    if (k + 96 < kq) tload(a1, b1, k + 96);
  }
  f32x4* red = (f32x4*)smem;
#pragma unroll
  for (int nt = 0; nt < 8; ++nt) red[(wave * 8 + nt) * 64 + lane] = acc[nt];
  __syncthreads();
#pragma unroll
  for (int q = 0; q < 2; ++q) {
    const int nt = wave * 2 + q;
    f32x4 v = red[(0 * 8 + nt) * 64 + lane] + red[(1 * 8 + nt) * 64 + lane] + red[(2 * 8 + nt) * 64 + lane] +
              red[(3 * 8 + nt) * 64 + lane];
    epi(M0 + l15, n0 + nt * 16 + quad * 4, v);
  }
  __syncthreads();
}

template <class Epi>
DEVI void gemm_phase(const bf16_t* A, int lda, const bf16_t* Bt, int K, int nnt, char* smem, Epi epi,
                     int skip = 0) {
  const int nmain = 64 * nnt, ntiles = nmain + nnt;
  const int nb = gridDim.x - skip;
  const int b = BIDX - skip;
  const bool xmap = (skip == 0) && ((nnt & 7) == 0) && ((nb & 63) == 0);
  const int q = xmap ? (b & 7) * (nb >> 3) + (b >> 3) : b;
  for (int t0 = 0; t0 < ntiles; t0 += nb) {
    const int t = t0 + q;
    if (t >= ntiles) break;
    if (t < nmain) {
      int mt, nt;
      if (xmap) {
        const int s_ = t >> 6, w_ = t & 63, spr = nnt >> 3;
        const int sm = s_ / spr, sn = s_ - sm * spr;
        mt = sm * 8 + (w_ >> 3);
        nt = sn * 8 + (w_ & 7);
      } else {
        mt = t / nnt;
        nt = t - mt * nnt;
      }
      gemm_tile256b(A, lda, Bt, K, mt * 256, nt * 128, smem, epi);
    } else {
      gemm_tail_tile(A, lda, Bt, K, (t - nmain) * 128, smem, epi);
    }
  }
}

struct EpiEvenIn {
  bf16_t* r0;
  DEVI void operator()(int m, int n, f32x4 v) const {
    if (n < 1024) {
      if (m >= L) return;
      const bool isq = n < 512;
      const int nn = n & 511;
      const int h = nn >> 7, c = (nn >> 6) & 1, d = nn & 63;
      const float s = isq ? (0.125f * LOG2E) : 1.0f;
      bf16_t* dst = isq ? r0 + R0_Q + ((size_t)(h * 2 + c) * LR + m) * 64 + d
                        : r0 + R0_K + (size_t)(h * 2 + c) * LR * 64 + wfm(m, d, 64);
      *(u32x2*)dst = u32x2{pack2(v[0] * s, v[1] * s), pack2(v[2] * s, v[3] * s)};
    } else if (n < 1536) {
      const int nn = n - 1024;
      bf16_t* dst = r0 + R0_VT + (size_t)nn * LR + m;
      const bool ok = m < L;
#pragma unroll
      for (int i = 0; i < 4; ++i) {
        dst[(size_t)i * LR] = ok ? f2bf(v[i]) : (bf16_t)0;
        if (m >= 16384) {
          dst[(size_t)i * LR + 16] = 0;
          dst[(size_t)i * LR + 32] = 0;
          dst[(size_t)i * LR + 48] = 0;
        }
      }
    } else {
      if (m >= L) return;
      bf16_t* dst = r0 + R0_U + (size_t)m * 512 + (n - 1536);
      *(u32x2*)dst = u32x2{pack2(v[0], v[1]), pack2(v[2], v[3])};
    }
  }
};
struct EpiResid {
  Params p;
  DEVI void operator()(int m, int n, f32x4 v) const {
    if (m >= L) return;
    float* h = hfrow(p, m) + n;
    f32x4 o = *(f32x4*)h;
    o = o * ALPHA + v;
    *(f32x4*)h = o;
  }
};
struct EpiOddIn {
  bf16_t* raw;
  float* ba;
  DEVI void operator()(int m, int n, f32x4 v) const {
    if (m >= L) return;
    if (n < 3072) {
      *(u32x2*)(raw + (size_t)m * 3072 + n) = u32x2{pack2(v[0], v[1]), pack2(v[2], v[3])};
    } else if (n < 3088) {
      *(f32x4*)(ba + (size_t)m * 16 + (n - 3072)) = v;
    }
  }
};
struct EpiZ {
  bf16_t* z;
  DEVI void operator()(int m, int n, f32x4 v) const {
    if (m >= L) return;
    *(u32x2*)(z + (size_t)m * 1024 + n) = u32x2{pack2(v[0], v[1]), pack2(v[2], v[3])};
  }
};
struct EpiSqRelu {
  bf16_t* hid;
  DEVI void operator()(int m, int n, f32x4 v) const {
    if (m >= L) return;
    float a = fmaxf(v[0], 0.f), b = fmaxf(v[1], 0.f), c = fmaxf(v[2], 0.f), d = fmaxf(v[3], 0.f);
    *(u32x2*)(hid + (size_t)m * 4096 + n) = u32x2{pack2(a * a, b * b), pack2(c * c, d * d)};
  }
};

DEVI void tconv_seg(const float* src, int ld, int krows, int c0, int ncols, int ndst, bf16_t* dst, int dld,
                    char* smem) {
  float* tile = (float*)smem;
  const int tid = TIDX;
  const int nkt = krows >> 6, nnt = (ndst + 63) >> 6;
  const int lr = tid >> 4, lc = (tid & 15) * 4;
  const int kp = tid & 31, wn = tid >> 5;
  for (int t = BIDX; t < nkt * nnt; t += gridDim.x) {
    const int kt = t % nkt, nt = t / nkt;
    const int k0 = kt * 64, n0 = nt * 64;
#pragma unroll
    for (int i = 0; i < 4; ++i) {
      const int r = i * 16 + lr;
      f32x4 v = f32x4{0.f, 0.f, 0.f, 0.f};
      if (n0 + lc < ncols) v = *(const f32x4*)(src + (size_t)(k0 + r) * ld + c0 + n0 + lc);
      tile[r * 65 + lc + 0] = v[0];
      tile[r * 65 + lc + 1] = v[1];
      tile[r * 65 + lc + 2] = v[2];
      tile[r * 65 + lc + 3] = v[3];
    }
    __syncthreads();
#pragma unroll
    for (int i = 0; i < 8; ++i) {
      const int rn = i * 8 + wn;
      if (n0 + rn < ndst)
        *(unsigned*)(dst + wfm(n0 + rn, k0 + 2 * kp, dld)) = pack2(tile[(2 * kp) * 65 + rn], tile[(2 * kp + 1) * 65 + rn]);
    }
    __syncthreads();
  }
}

DEVI void convert_layer(const Params& p, int layer, char* smem) {
  bf16_t* wb = (bf16_t*)(p.ws + OFF_WB);
  const int j = layer >> 1;
  if ((layer & 1) == 0) {
    tconv_seg(p.in[3] + (size_t)j * 1024 * 2048, 2048, 1024, 0, 2048, 2048, wb + WB_IN, 1024, smem);
    tconv_seg(p.in[8] + (size_t)j * 1024 * 1024, 1024, 512, 0, 1024, 1024, wb + WB_OUT, 1024, smem);
    const float* pw = p.in[6] + (size_t)j * 4 * 128 * 128;
    const float* ps = p.in[7] + (size_t)j * 512;
    const float* wo = p.in[8] + (size_t)j * 1024 * 1024;
    {
      const int tid = TIDX;
      for (int item = BIDX; item < 512; item += gridDim.x) {
        const int g = item >> 7, c = item & 127;
        const float* pwr = pw + ((size_t)g * 128 + c) * 128;
        const float* wor = wo + (size_t)(512 + g * 128) * 1024 + tid * 4;
        f32x4 acc = f32x4{0.f, 0.f, 0.f, 0.f};
#pragma unroll 8
        for (int d = 0; d < 128; ++d) {
          const float a = pwr[d] * ps[g * 128 + d];
          const f32x4 w4 = *(const f32x4*)(wor + (size_t)d * 1024);
          acc = acc + w4 * a;
        }
#pragma unroll
        for (int e = 0; e < 4; ++e) wb[WB_OUT + wfm(tid * 4 + e, 512 + item, 1024)] = f2bf(acc[e]);
      }
    }
  } else {
    const float* wi = p.in[9] + (size_t)j * 1024 * 4112;
    tconv_seg(wi, 4112, 1024, 0, 3072, 3072, wb + WB_IN, 1024, smem);
    tconv_seg(wi, 4112, 1024, 4096, 16, 128, wb + WB_IN + (size_t)3072 * 1024, 1024, smem);
    tconv_seg(wi, 4112, 1024, 3072, 1024, 1024, wb + WB_Z, 1024, smem);
    tconv_seg(p.in[14] + (size_t)j * 1024 * 1024, 1024, 1024, 0, 1024, 1024, wb + WB_OUT, 1024, smem);
  }
  tconv_seg(p.in[15] + (size_t)layer * 1024 * 4096, 4096, 1024, 0, 4096, 4096, wb + WB_W1, 1024, smem);
  tconv_seg(p.in[16] + (size_t)layer * 4096 * 1024, 1024, 4096, 0, 1024, 1024, wb + WB_W2, 4096, smem);
}

DEVI void init_phase(const Params& p) {
  const int gt = BIDX * 256 + TIDX, nth = gridDim.x * 256;
  if (gt < 64) ((int*)(p.ws + OFF_MISC))[gt] = 0;
  bf16_t* hb = (bf16_t*)(p.ws + OFF_HB);
  for (int idx = gt; idx < L * 256; idx += nth) {
    const int t = idx >> 8, c = (idx & 255) * 4;
    f32x4 v = (t < 16) ? *(const f32x4*)(p.in[1] + t * 1024 + c) : *(const f32x4*)(p.in[0] + (size_t)(t - 16) * 1024 + c);
    *(f32x4*)(hfrow(p, t) + c) = v;
    *(u32x2*)(hb + (size_t)t * 1024 + c) = u32x2{pack2(v[0], v[1]), pack2(v[2], v[3])};
  }
}

DEVI void ln_phase(const Params& p, const float* g, const float* b) {
  const int tid = TIDX;
  const int lane = tid & 63;
  const int gw = BIDX * 4 + (tid >> 6), nw = gridDim.x * 4;
  bf16_t* hb = (bf16_t*)(p.ws + OFF_HB);
  for (int t0 = gw * 4; t0 < L; t0 += nw * 4) {
    f32x4 v[4][4];
    float* h[4];
#pragma unroll
    for (int r = 0; r < 4; ++r) {
      h[r] = hfrow(p, t0 + r);
#pragma unroll
      for (int i = 0; i < 4; ++i) v[r][i] = *(const f32x4*)(h[r] + i * 256 + lane * 4);
    }
    float s[4], q[4];
#pragma unroll
    for (int r = 0; r < 4; ++r) {
      s[r] = 0.f;
#pragma unroll
      for (int i = 0; i < 4; ++i) s[r] += v[r][i][0] + v[r][i][1] + v[r][i][2] + v[r][i][3];
    }
#pragma unroll
    for (int m = 32; m >= 1; m >>= 1) {
#pragma unroll
      for (int r = 0; r < 4; ++r) s[r] += __shfl_xor(s[r], m);
    }
#pragma unroll
    for (int r = 0; r < 4; ++r) {
      const float mu = s[r] * (1.f / 1024.f);
      q[r] = 0.f;
#pragma unroll
      for (int i = 0; i < 4; ++i) {
        v[r][i] = v[r][i] - mu;
        q[r] += v[r][i][0] * v[r][i][0] + v[r][i][1] * v[r][i][1] + v[r][i][2] * v[r][i][2] + v[r][i][3] * v[r][i][3];
      }
    }
#pragma unroll
    for (int m = 32; m >= 1; m >>= 1) {
#pragma unroll
      for (int r = 0; r < 4; ++r) q[r] += __shfl_xor(q[r], m);
    }
#pragma unroll
    for (int i = 0; i < 4; ++i) {
      const f32x4 gg = *(const f32x4*)(g + i * 256 + lane * 4);
      const f32x4 bb = *(const f32x4*)(b + i * 256 + lane * 4);
#pragma unroll
      for (int r = 0; r < 4; ++r) {
        const float rstd = rsqrtf(q[r] * (1.f / 1024.f) + 1e-5f);
        f32x4 y = v[r][i] * rstd * gg + bb;
        *(f32x4*)(h[r] + i * 256 + lane * 4) = y;
        *(u32x2*)(hb + (size_t)(t0 + r) * 1024 + i * 256 + lane * 4) = u32x2{pack2(y[0], y[1]), pack2(y[2], y[3])};
      }
    }
  }
}

constexpr int POOL_CHUNK = 2048, POOL_NCHUNK = (L * 64 + POOL_CHUNK - 1) / POOL_CHUNK;
DEVI void pool_chunk(const Params& p, int chunk) {
  const bf16_t* U = (const bf16_t*)(p.ws + OFF_R0) + R0_U;
  bf16_t* cat = (bf16_t*)(p.ws + OFF_R1);
  const int tid_ = TIDX;
  const int lim = min((chunk + 1) * POOL_CHUNK, L * 64);
  for (int idx = chunk * POOL_CHUNK + tid_; idx < lim; idx += 256) {
    const int t = idx >> 6, cc = idx & 63, g = cc >> 4;
    const int win = 2 << g;
    const int cnt = min(t + 1, win);
    float s[8];
#pragma unroll
    for (int e = 0; e < 8; ++e) s[e] = 0.f;
    u32x4 self = u32x4{0, 0, 0, 0};
    u32x4 tv[16];
#pragma unroll
    for (int k = 0; k < 16; ++k) {
      tv[k] = u32x4{0, 0, 0, 0};
      if (k < cnt) tv[k] = *(const u32x4*)(U + (size_t)(t - k) * 512 + cc * 8);
    }
    self = tv[0];
#pragma unroll
    for (int k = 0; k < 16; ++k) {
#pragma unroll
      for (int e = 0; e < 4; ++e) {
        s[2 * e] += bflo(tv[k][e]);
        s[2 * e + 1] += bfhi(tv[k][e]);
      }
    }
    const float inv = 1.f / (float)cnt;
    u32x4 o;
#pragma unroll
    for (int e = 0; e < 4; ++e) o[e] = pack2(s[2 * e] * inv - bflo(self[e]), s[2 * e + 1] * inv - bfhi(self[e]));
    *(u32x4*)(cat + (size_t)t * 1024 + 512 + cc * 8) = o;
  }
}

DEVI void attn_item(const Params& p, int j, int h, int qt, float lam, float one_m_linit, char* smem) {
  const int tid = TIDX, lane = tid & 63, wave = tid >> 6;
  const int rg = wave & 1, c = wave >> 1, l15 = lane & 15, quad = lane >> 4;
  const bf16_t* r0 = (const bf16_t*)(p.ws + OFF_R0);
  const bf16_t* Qg = r0 + R0_Q + (size_t)(h * 2 + c) * LR * 64;
  const bf16_t* Kfm = r0 + R0_K + (size_t)(h * 2 + c) * LR * 64 + lane * 8;
  const bf16_t* Vg = r0 + R0_VT + (size_t)(h * 128) * LR;
  const float* tbl = (const float*)(smem + 73728);
  const int q0 = qt * 64;
  const int qw = q0 + rg * 32;
  bf16x8 qf[2][2];
#pragma unroll
  for (int qi = 0; qi < 2; ++qi)
#pragma unroll
    for (int ks = 0; ks < 2; ++ks)
      qf[qi][ks] = *(const bf16x8*)(Qg + (size_t)(qw + qi * 16 + l15) * 64 + ks * 32 + quad * 8);
  f32x4 oacc[2][8];
#pragma unroll
  for (int qi = 0; qi < 2; ++qi)
#pragma unroll
    for (int d = 0; d < 8; ++d) oacc[qi][d] = f32x4{0.f, 0.f, 0.f, 0.f};
  float mrun[2] = {0.f, 0.f};
  f32x4 lacc[2] = {f32x4{0.f, 0.f, 0.f, 0.f}, f32x4{0.f, 0.f, 0.f, 0.f}};
  const bf16x8 ones = {16256, 16256, 16256, 16256, 16256, 16256, 16256, 16256};
  const int nkt = qt + 1;
  const int krow = tid >> 3, kkc = tid & 7;
  u32x4 rv[4];
  auto gload = [&](int kt) {
    const int k0 = kt * 64;
#pragma unroll
    for (int i = 0; i < 4; ++i) rv[i] = *(const u32x4*)(Vg + (size_t)(krow + i * 32) * LR + k0 + kkc * 8);
  };
  auto lstore = [&](int buf) {
    char* b = smem + buf * 34816;
#pragma unroll
    for (int i = 0; i < 4; ++i) *(u32x4*)(b + 16384 + (krow + i * 32) * 144 + kkc * 16) = rv[i];
  };
  bf16x8 kf[4][2];
  auto kload = [&](int kt) {
#pragma unroll
    for (int ki = 0; ki < 4; ++ki)
#pragma unroll
      for (int ks = 0; ks < 2; ++ks) kf[ki][ks] = *(const bf16x8*)(Kfm + ((size_t)((kt * 4 + ki) * 2 + ks)) * 512);
  };
  gload(0);
  kload(0);
  lstore(0);
  __syncthreads();
  for (int kt = 0; kt < nkt; ++kt) {
    const char* b = smem + (kt & 1) * 34816;
    if (kt + 1 < nkt) gload(kt + 1);
    const int k0 = kt * 64;
    if (k0 <= qw + 31) {
      f32x4 st[2][4];
#pragma unroll
      for (int qi = 0; qi < 2; ++qi)
#pragma unroll
        for (int ki = 0; ki < 4; ++ki) st[qi][ki] = f32x4{-mrun[qi], -mrun[qi], -mrun[qi], -mrun[qi]};
      const char* vb = b + 16384;
      bf16x8 vf[2][4];
      auto vload = [&](int g, int slot) {
#pragma unroll
        for (int dd = 0; dd < 2; ++dd)
#pragma unroll
          for (int s2 = 0; s2 < 2; ++s2) {
            const char* a = vb + ((g * 2 + dd) * 16 + l15) * 144 + s2 * 64 + quad * 8;
            vf[slot][dd * 2 + s2] = mk8(*(const u32x2*)a, *(const u32x2*)(a + 32));
          }
      };
      __builtin_amdgcn_s_setprio(2);
#pragma unroll
      for (int ki = 0; ki < 4; ++ki)
#pragma unroll
        for (int ks = 0; ks < 2; ++ks) {
#pragma unroll
          for (int qi = 0; qi < 2; ++qi) st[qi][ki] = MFMA16(kf[ki][ks], qf[qi][ks], st[qi][ki]);
        }
      __builtin_amdgcn_s_setprio(0);
      if (kt + 1 < nkt) kload(kt + 1);
      __builtin_amdgcn_sched_barrier(0);
      const bool far = (qw - (k0 + 63)) >= 128;
      const bool first = (kt == 0);
#pragma unroll
      for (int qi = 0; qi < 2; ++qi) {
        if (!far) {
          const int qpos = qw + qi * 16 + l15;
#pragma unroll
          for (int ki = 0; ki < 4; ++ki)
#pragma unroll
            for (int jj = 0; jj < 4; ++jj) {
              const int n = qpos - (k0 + ki * 16 + quad * 4 + jj);
              st[qi][ki][jj] = (n >= 0) ? st[qi][ki][jj] + tbl[min(n, 128)] : -1e30f;
            }
        }
        float tmax = st[qi][0][0];
#pragma unroll
        for (int ki = 0; ki < 4; ++ki)
#pragma unroll
          for (int jj = 0; jj < 4; jj += 2) tmax = fmaxf(fmaxf(tmax, st[qi][ki][jj]), st[qi][ki][jj + 1]);
        tmax = fmaxf(tmax, __shfl_xor(tmax, 16));
        tmax = fmaxf(tmax, __shfl_xor(tmax, 32));
        if (first || __any(tmax > 8.0f)) {
          const float dm = first ? tmax : fmaxf(tmax, 0.f);
          const float alpha = __builtin_amdgcn_exp2f(-dm);
          mrun[qi] += dm;
          lacc[qi] = lacc[qi] * alpha;
#pragma unroll
          for (int d = 0; d < 8; ++d) oacc[qi][d] = oacc[qi][d] * alpha;
#pragma unroll
          for (int ki = 0; ki < 4; ++ki) st[qi][ki] = st[qi][ki] - dm;
        }
#pragma unroll
        for (int ki = 0; ki < 4; ++ki)
#pragma unroll
          for (int jj = 0; jj < 4; ++jj) st[qi][ki][jj] = __builtin_amdgcn_exp2f(st[qi][ki][jj]);
      }
      vload(0, 0);
      bf16x8 pb[2][2];
#pragma unroll
      for (int qi = 0; qi < 2; ++qi)
#pragma unroll
        for (int s2 = 0; s2 < 2; ++s2) pb[qi][s2] = pack8(st[qi][2 * s2], st[qi][2 * s2 + 1]);
      __builtin_amdgcn_s_setprio(2);
#pragma unroll
      for (int qi = 0; qi < 2; ++qi)
#pragma unroll
        for (int s2 = 0; s2 < 2; ++s2) lacc[qi] = MFMA16(ones, pb[qi][s2], lacc[qi]);
#pragma unroll
      for (int g = 0; g < 4; ++g) {
        if (g < 3) vload(g + 1, (g + 1) & 1);
#pragma unroll
        for (int dd = 0; dd < 2; ++dd)
#pragma unroll
          for (int s2 = 0; s2 < 2; ++s2)
#pragma unroll
            for (int qi = 0; qi < 2; ++qi)
              oacc[qi][g * 2 + dd] = MFMA16(vf[g & 1][dd * 2 + s2], pb[qi][s2], oacc[qi][g * 2 + dd]);
        __builtin_amdgcn_sched_barrier(0);
      }
      __builtin_amdgcn_s_setprio(0);
    }
    if (kt + 1 < nkt) lstore((kt + 1) & 1);
    __syncthreads();
  }
#pragma unroll
  for (int qi = 0; qi < 2; ++qi) {
    const float inv = 1.f / lacc[qi][0];
#pragma unroll
    for (int d = 0; d < 8; ++d) oacc[qi][d] = oacc[qi][d] * inv;
  }
  f32x4* xb = (f32x4*)smem;
  if (c == 1) {
#pragma unroll
    for (int qi = 0; qi < 2; ++qi)
#pragma unroll
      for (int d = 0; d < 8; ++d) xb[((rg * 2 + qi) * 8 + d) * 64 + lane] = oacc[qi][d];
  }
  __syncthreads();
  if (c == 0) {
    const float* sw = p.in[5] + j * 128;
    bf16_t* cat = (bf16_t*)(p.ws + OFF_R1);
#pragma unroll
    for (int qi = 0; qi < 2; ++qi) {
      float ss = 0.f;
#pragma unroll
      for (int d = 0; d < 8; ++d) {
        f32x4 o1 = xb[((rg * 2 + qi) * 8 + d) * 64 + lane];
        f32x4 o = oacc[qi][d] - o1 * lam;
        oacc[qi][d] = o;
        ss += o[0] * o[0] + o[1] * o[1] + o[2] * o[2] + o[3] * o[3];
      }
      ss += __shfl_xor(ss, 16);
      ss += __shfl_xor(ss, 32);
      const float r = rsqrtf(ss * (1.f / 128.f) + 1e-6f) * one_m_linit;
      const int qpos = qw + qi * 16 + l15;
      if (qpos < L) {
#pragma unroll
        for (int d = 0; d < 8; ++d) {
          const int dv = d * 16 + quad * 4;
          f32x4 w = *(const f32x4*)(sw + dv);
          f32x4 o = oacc[qi][d] * r * w;
          *(u32x2*)(cat + (size_t)qpos * 1024 + h * 128 + dv) = u32x2{pack2(o[0], o[1]), pack2(o[2], o[3])};
        }
      }
    }
  }
  __syncthreads();
}

DEVI void attn_phase(const Params& p, int j, float lambda_init, char* smem, int* s_item) {
  const int tid = TIDX;
  const float* lv = p.in[4] + j * 256;
  float d01 = 0.f, d23 = 0.f;
  for (int i = 0; i < 64; ++i) {
    d01 += lv[i] * lv[64 + i];
    d23 += lv[128 + i] * lv[192 + i];
  }
  const float lam = expf(d01) - expf(d23) + lambda_init;
  float* tbl = (float*)(smem + 73728);
  int cur_h = -1;
  const int x0 = (int)(xb_xcc_id() & 7u);
  for (int qx = 0; qx < 8; ++qx) {
    const int xq = (x0 + qx) & 7;
    int* counter = (int*)(p.ws + OFF_MISC) + 16 + j * 8 + xq;
    const int h = xq >> 1, par = xq & 1, nq = par ? 128 : 129;
    for (;;) {
      if (tid == 0) *s_item = atomicAdd(counter, 1);
      __syncthreads();
      const int item = *s_item;
      __syncthreads();
      if (item >= nq) break;
      const int qt = (par ? 255 : 256) - 2 * item;
      if (h != cur_h) {
        if (tid < 129) {
          int bucket;
          if (tid < 16) bucket = tid;
          else {
            bucket = 16 + (int)(logf((float)tid / 16.0f) / 2.0794415416798357f * 16.0f);
            bucket = min(bucket, 31);
          }
          tbl[tid] = (p.in[2][bucket * 4 + h] - p.in[2][31 * 4 + h]) * LOG2E;
        }
        cur_h = h;
        __syncthreads();
      }
      attn_item(p, j, h, qt, lam, 1.0f - lambda_init, smem);
    }
  }
  int* pctr = (int*)(p.ws + OFF_MISC) + 8 + j;
  for (;;) {
    if (tid == 0) *s_item = atomicAdd(pctr, 1);
    __syncthreads();
    const int c = *s_item;
    __syncthreads();
    if (c >= POOL_NCHUNK) break;
    pool_chunk(p, c);
  }
}

DEVI void conv_phase(const Params& p, int j) {
  const bf16_t* raw = (const bf16_t*)(p.ws + OFF_R0);
  bf16_t* r1 = (bf16_t*)(p.ws + OFF_R1);
  const float* cw = p.in[10] + (size_t)j * 3072 * 4;
  const int tid = TIDX;
  const int lane = tid & 63;
  const int gw = BIDX * 4 + (tid >> 6), nw = gridDim.x * 4;
  for (int item = gw; item < 1025 * 24; item += nw) {
    const int run = item / 24, seg = item - run * 24;
    const int tb = run * 16;
    const int ch = seg * 128 + lane * 2;
    const f32x4 w0 = *(const f32x4*)(cw + (size_t)ch * 4);
    const f32x4 w1 = *(const f32x4*)(cw + (size_t)ch * 4 + 4);
    unsigned xv[19];
#pragma unroll
    for (int r = 0; r < 19; ++r) {
      const int tt = tb - 3 + r;
      xv[r] = 0;
      if (tt >= 0) xv[r] = *(const unsigned*)(raw + (size_t)tt * 3072 + ch);
    }
    float y0[16], y1[16], ss[16];
#pragma unroll
    for (int i = 0; i < 16; ++i) {
      float a0 = 0.f, a1 = 0.f;
#pragma unroll
      for (int k = 0; k < 4; ++k) {
        a0 += w0[k] * bflo(xv[i + k]);
        a1 += w1[k] * bfhi(xv[i + k]);
      }
      a0 = a0 / (1.f + __expf(-a0));
      a1 = a1 / (1.f + __expf(-a1));
      y0[i] = a0;
      y1[i] = a1;
      ss[i] = a0 * a0 + a1 * a1;
    }
    if (seg < 16) {
#pragma unroll
      for (int m = 32; m >= 1; m >>= 1) {
#pragma unroll
        for (int i = 0; i < 16; ++i) ss[i] += __shfl_xor(ss[i], m);
      }
      const float sc = (seg < 8) ? 0.08838834764831845f : 1.0f;
#pragma unroll
      for (int i = 0; i < 16; ++i) {
        const float r = rsqrtf(ss[i] + 1e-6f) * sc;
        y0[i] *= r;
        y1[i] *= r;
      }
    }
    int chw = ch;
    if (seg < 8) {
      const int cc = lane * 2;
      chw = seg * 128 + (cc & 96) + (((cc >> 2) & 3) << 3) + (((cc >> 4) & 1) << 2) + (cc & 3);
    }
#pragma unroll
    for (int i = 0; i < 16; ++i) *(unsigned*)(r1 + (size_t)(tb + i) * 3072 + chw) = pack2(y0[i], y1[i]);
  }
}

DEVI void prep_item(const Params& p, int j, int n, int h, char* smem) {
  const int tid = TIDX, lane = tid & 63, wave = tid >> 6, l15 = lane & 15, quad = lane >> 4;
  bf16_t* r1 = (bf16_t*)(p.ws + OFF_R1);
  bf16_t* r0 = (bf16_t*)(p.ws + OFF_R0);
  const float* ba = (const float*)(p.ws + OFF_BA);
  char* qs = smem;
  char* ks = smem + 17408;
  char* vs = smem + 34816;
  float* am = (float*)(smem + 52224);
  float* sbeta = (float*)(smem + 69632);
  float* sgc = sbeta + 64;
  const int t0 = n * 64 - 48;
#pragma unroll
  for (int i = 0; i < 4; ++i) {
    const int ch = tid + i * 256, row = ch >> 4, kc = ch & 15;
    const int t = t0 + row;
    u32x4 vq = u32x4{0, 0, 0, 0}, vk = vq, vv = vq;
    if (t >= 0) {
      const bf16_t* src = r1 + (size_t)t * 3072 + h * 128 + kc * 8;
      vq = *(const u32x4*)src;
      vk = *(const u32x4*)(src + 1024);
      vv = *(const u32x4*)(src + 2048);
    }
    {
      const int s_ = kc >> 2, q_ = kc & 3;
      *(u32x2*)(qs + row * 272 + (s_ * 32 + q_ * 4) * 2) = u32x2{vq.x, vq.y};
      *(u32x2*)(qs + row * 272 + (s_ * 32 + 16 + q_ * 4) * 2) = u32x2{vq.z, vq.w};
    }
    *(u32x4*)(ks + row * 272 + kc * 16) = vk;
    *(u32x4*)(vs + row * 272 + kc * 16) = vv;
  }
  if (wave == 0) {
    const int t = t0 + lane;
    float beta = 0.f, g = 0.f;
    if (t >= 0) {
      const float braw = ba[(size_t)t * 16 + h], araw = ba[(size_t)t * 16 + 8 + h];
      beta = 1.f / (1.f + expf(-braw));
      const float x = araw + p.in[12][j * 8 + h];
      const float sp = (x > 20.f) ? x : log1pf(expf(x));
      g = -expf(p.in[11][j * 8 + h]) * sp;
    }
#pragma unroll
    for (int off = 1; off < 64; off <<= 1) {
      const float o = __shfl_up(g, off);
      if (lane >= off) g += o;
    }
    sbeta[lane] = beta;
    sgc[lane] = g;
    {
      const float glast = __shfl(g, 63);
      float* gout = (float*)(r0 + R0_G) + (size_t)(n * 8 + h) * 192;
      gout[lane] = __expf(g);
      gout[64 + lane] = __expf(glast - g);
      if (lane == 0) gout[128] = __expf(glast);
    }
  }
  __syncthreads();
  {
    f32x4 akk[4], aqk[4];
#pragma unroll
    for (int nt = 0; nt < 4; ++nt) akk[nt] = aqk[nt] = f32x4{0.f, 0.f, 0.f, 0.f};
#pragma unroll
    for (int s = 0; s < 4; ++s) {
      bf16x8 ka = *(const bf16x8*)(ks + (wave * 16 + l15) * 272 + s * 64 + quad * 16);
      bf16x8 qa = *(const bf16x8*)(qs + (wave * 16 + l15) * 272 + s * 64 + quad * 16);
#pragma unroll
      for (int nt = 0; nt < 4; ++nt) {
        bf16x8 kb = *(const bf16x8*)(ks + (nt * 16 + l15) * 272 + s * 64 + quad * 16);
        akk[nt] = MFMA16(ka, kb, akk[nt]);
        aqk[nt] = MFMA16(qa, kb, aqk[nt]);
      }
    }
    bf16_t* qkout = r0 + R0_QK + (size_t)(n * 8 + h) * 4096;
#pragma unroll
    for (int nt = 0; nt < 4; ++nt) {
      const int jx = nt * 16 + l15;
      const float gj = sgc[jx];
#pragma unroll
      for (int jj = 0; jj < 4; ++jj) {
        const int i = wave * 16 + quad * 4 + jj;
        const float dec = __expf(fminf(sgc[i] - gj, 0.f));
        am[i * 68 + jx] = (jx < i) ? sbeta[i] * akk[nt][jj] * dec : 0.f;
        qkout[i * 64 + jx] = f2bf((jx <= i) ? aqk[nt][jj] * dec : 0.f);
      }
    }
  }
  __syncthreads();
  {
    bf16_t* kt = r0 + R0_KT + (size_t)(n * 8 + h) * 8192;
#pragma unroll
    for (int i = 0; i < 4; ++i) {
      const int unit = tid + i * 256, d = unit >> 3, i0 = (unit & 7) * 8;
      unsigned e[8];
#pragma unroll
      for (int q = 0; q < 8; ++q) e[q] = *(const unsigned short*)(ks + (i0 + q) * 272 + d * 2);
      u32x4 o = {e[0] | (e[1] << 16), e[2] | (e[3] << 16), e[4] | (e[5] << 16), e[6] | (e[7] << 16)};
      *(u32x4*)(kt + d * 64 + i0) = o;
    }
  }
  {
    const int c = tid;
    const bool isu = c < 128;
    const char* src = isu ? (vs + c * 2) : (ks + (c - 128) * 2);
    float x[64];
#pragma unroll
    for (int i = 0; i < 64; ++i) x[i] = 0.f;
    int zero;
    asm volatile("v_mov_b32 %0, 0" : "=v"(zero));
#pragma unroll
    for (int i = 0; i < 64; ++i) {
      const float* amz = am + zero;
      const float* sbz = sbeta + zero;
      const float eg = __expf(sbz[64 + i]);
      float acc = bf2f(*(const unsigned short*)(src + i * 272)) * sbz[i] * (isu ? 1.0f : eg);
#pragma unroll
      for (int j4 = 0; j4 < (i + 3) / 4; ++j4) {
        const f32x4 a = *(const f32x4*)(amz + i * 68 + j4 * 4);
        acc -= a[0] * x[j4 * 4 + 0];
        acc -= a[1] * x[j4 * 4 + 1];
        acc -= a[2] * x[j4 * 4 + 2];
        acc -= a[3] * x[j4 * 4 + 3];
      }
      asm volatile("" : "+v"(zero), "+v"(acc));
      x[i] = acc;
    }
    bf16_t* dst = r1 + (isu ? 2048 : 1024) + h * 128 + (c & 127);
#pragma unroll
    for (int i = 0; i < 64; ++i) {
      const int t = t0 + i;
      if (t >= 0) dst[(size_t)t * 3072] = f2bf(x[i]);
    }
  }
  __syncthreads();
}

constexpr int NW = 2;
DEVI void scan_item(const Params& p, int h, int sl, char* smem) {
  const int tid = TIDX, lane = tid & 63, wave = tid >> 6, l15 = lane & 15, quad = lane >> 4;
  bf16_t* r1 = (bf16_t*)(p.ws + OFF_R1);
  const bf16_t* r0 = (const bf16_t*)(p.ws + OFF_R0);
  char* wsm = smem;
  char* qksm = smem + 17408;
  char* ktsm = smem + 26624;
  char* usm = smem + 45056;
  float* gsm = (float*)(smem + 50176);
  char* sbx = smem + 51200;
  char* vbx = smem + 59392;
  constexpr int USTR = (NW * 16 + 8) * 2;
  const int vb0 = sl * NW * 16;
  const bool is_state = wave < NW;
  const int cw = is_state ? wave : wave - NW;
  u32x4 pw[4], pqk[2], pkt[4], pg = u32x4{0, 0, 0, 0}, pu = u32x4{0, 0, 0, 0};
  auto gload = [&](int n) {
    const int t0 = n * 64 - 48;
#pragma unroll
    for (int i = 0; i < 4; ++i) {
      const int ch = tid + i * 256, row = ch >> 4, kc = ch & 15;
      const int t = t0 + row;
      pw[i] = u32x4{0, 0, 0, 0};
      if (t >= 0) pw[i] = *(const u32x4*)(r1 + (size_t)t * 3072 + 1024 + h * 128 + kc * 8);
    }
    const bf16_t* qk = r0 + R0_QK + (size_t)(n * 8 + h) * 4096;
#pragma unroll
    for (int i = 0; i < 2; ++i) pqk[i] = *(const u32x4*)(qk + (size_t)(tid + i * 256) * 8);
    const bf16_t* kt = r0 + R0_KT + (size_t)(n * 8 + h) * 8192;
#pragma unroll
    for (int i = 0; i < 4; ++i) pkt[i] = *(const u32x4*)(kt + (size_t)(tid + i * 256) * 8);
    if (tid < 48) pg = *(const u32x4*)((const float*)(r0 + R0_G) + (size_t)(n * 8 + h) * 192 + tid * 4);
    if (tid < 64 * NW * 2) {
      const int row = tid / (NW * 2), kc = tid % (NW * 2);
      const int t = t0 + row;
      pu = u32x4{0, 0, 0, 0};
      if (t >= 0) pu = *(const u32x4*)(r1 + (size_t)t * 3072 + 2048 + h * 128 + vb0 + kc * 8);
    }
  };
  auto lstore = [&]() {
#pragma unroll
    for (int i = 0; i < 4; ++i) {
      const int ch = tid + i * 256, row = ch >> 4, kc = ch & 15;
      *(u32x4*)(wsm + row * 272 + kc * 16) = pw[i];
    }
    if (tid < 48) *(u32x4*)(gsm + tid * 4) = pg;
    if (tid < 64 * NW * 2) {
      const int row = tid / (NW * 2), kc = tid % (NW * 2);
      *(u32x4*)(usm + row * USTR + kc * 16) = pu;
    }
  };
  auto lstore2 = [&]() {
#pragma unroll
    for (int i = 0; i < 2; ++i) {
      const int ch = tid + i * 256, row = ch >> 3, kc = ch & 7;
      *(u32x4*)(qksm + row * 144 + kc * 16) = pqk[i];
    }
#pragma unroll
    for (int i = 0; i < 4; ++i) {
      const int ch = tid + i * 256, row = ch >> 3, kc = ch & 7;
      *(u32x4*)(ktsm + row * 144 + kc * 16) = pkt[i];
    }
  };
  bf16x8 qfr[2][4];
  auto qload = [&](int n) {
    const int t0 = n * 64 - 48;
#pragma unroll
    for (int mt = 0; mt < 2; ++mt) {
      const int t = t0 + (cw * 2 + mt) * 16 + l15;
#pragma unroll
      for (int s = 0; s < 4; ++s) {
        u32x4 v4 = u32x4{0, 0, 0, 0};
        if (t >= 0) v4 = *(const u32x4*)(r1 + (size_t)t * 3072 + h * 128 + s * 32 + quad * 8);
        qfr[mt][s] = __builtin_bit_cast(bf16x8, v4);
      }
    }
  };
  f32x4 S[8];
#pragma unroll
  for (int r = 0; r < 8; ++r) S[r] = f32x4{0.f, 0.f, 0.f, 0.f};
  gload(0);
  if (!is_state) qload(0);
  for (int n = 0; n < NCH; ++n) {
    lstore();
    if (is_state) {
#pragma unroll
      for (int s = 0; s < 4; ++s) *(bf16x8*)(sbx + ((cw * 4 + s) * 64 + lane) * 16) = pack8(S[2 * s], S[2 * s + 1]);
    }
    __syncthreads();
    lstore2();
    if (n + 1 < NCH) gload(n + 1);
    if (is_state) {
      bf16x8 sb[4];
#pragma unroll
      for (int s = 0; s < 4; ++s) sb[s] = pack8(S[2 * s], S[2 * s + 1]);
      f32x4 vnew[4];
#pragma unroll
      for (int mt = 0; mt < 4; ++mt) vnew[mt] = f32x4{0.f, 0.f, 0.f, 0.f};
#pragma unroll
      for (int s = 0; s < 4; ++s) {
#pragma unroll
        for (int mt = 0; mt < 4; ++mt) {
          const char* aw = wsm + (mt * 16 + l15) * 272 + s * 64 + quad * 8;
          bf16x8 wf = mk8(*(const u32x2*)aw, *(const u32x2*)(aw + 32));
          vnew[mt] = MFMA16(wf, sb[s], vnew[mt]);
        }
      }
#pragma unroll
      for (int mt = 0; mt < 4; ++mt) {
#pragma unroll
        for (int jj = 0; jj < 4; ++jj) {
          const int cidx = mt * 16 + quad * 4 + jj;
          const float u = bf2f(*(const unsigned short*)(usm + cidx * USTR + (cw * 16 + l15) * 2));
          vnew[mt][jj] = u - vnew[mt][jj];
        }
      }
#pragma unroll
      for (int s2 = 0; s2 < 2; ++s2)
        *(bf16x8*)(vbx + ((cw * 2 + s2) * 64 + lane) * 16) = pack8(vnew[2 * s2], vnew[2 * s2 + 1]);
      __syncthreads();
      const float eglast = gsm[128];
      bf16x8 vb[2];
#pragma unroll
      for (int mt = 0; mt < 4; ++mt) {
        const f32x4 gd4 = *(const f32x4*)(gsm + 64 + mt * 16 + quad * 4);
        vnew[mt] = vnew[mt] * gd4;
      }
#pragma unroll
      for (int s2 = 0; s2 < 2; ++s2) vb[s2] = pack8(vnew[2 * s2], vnew[2 * s2 + 1]);
#pragma unroll
      for (int r = 0; r < 8; ++r) S[r] = S[r] * eglast;
#pragma unroll
      for (int s2 = 0; s2 < 2; ++s2) {
#pragma unroll
        for (int r = 0; r < 8; ++r) {
          const char* ap = ktsm + (r * 16 + l15) * 144 + s2 * 64 + quad * 8;
          bf16x8 f = mk8(*(const u32x2*)ap, *(const u32x2*)(ap + 32));
          S[r] = MFMA16(f, vb[s2], S[r]);
        }
      }
    } else {
      f32x4 acco[2][NW];
#pragma unroll
      for (int ct = 0; ct < NW; ++ct) {
        bf16x8 sb[4];
#pragma unroll
        for (int s = 0; s < 4; ++s) sb[s] = *(const bf16x8*)(sbx + ((ct * 4 + s) * 64 + lane) * 16);
#pragma unroll
        for (int m = 0; m < 2; ++m) acco[m][ct] = f32x4{0.f, 0.f, 0.f, 0.f};
#pragma unroll
        for (int s = 0; s < 4; ++s)
#pragma unroll
          for (int m = 0; m < 2; ++m) acco[m][ct] = MFMA16(qfr[m][s], sb[s], acco[m][ct]);
      }
      if (n + 1 < NCH) qload(n + 1);
      __syncthreads();
      const int t0 = n * 64 - 48;
#pragma unroll
      for (int m = 0; m < 2; ++m) {
        const int mt = cw * 2 + m;
        bf16x8 qkf[2];
#pragma unroll
        for (int s2 = 0; s2 < 2; ++s2) {
          const char* a = qksm + (mt * 16 + l15) * 144 + s2 * 64 + quad * 8;
          qkf[s2] = mk8(*(const u32x2*)a, *(const u32x2*)(a + 32));
        }
        const f32x4 ge4 = *(const f32x4*)(gsm + mt * 16 + quad * 4);
#pragma unroll
        for (int ct = 0; ct < NW; ++ct) {
          f32x4 a2 = f32x4{0.f, 0.f, 0.f, 0.f};
#pragma unroll
          for (int s2 = 0; s2 < 2; ++s2) {
            const bf16x8 vb = *(const bf16x8*)(vbx + ((ct * 2 + s2) * 64 + lane) * 16);
            a2 = MFMA16(qkf[s2], vb, a2);
          }
#pragma unroll
          for (int jj = 0; jj < 4; ++jj) {
            const int t = t0 + mt * 16 + quad * 4 + jj;
            const float o = ge4[jj] * acco[m][ct][jj] + a2[jj];
            if (t >= 0) r1[(size_t)t * 3072 + 2048 + h * 128 + vb0 + ct * 16 + l15] = f2bf(o);
          }
        }
      }
    }
    __syncthreads();
  }
}

DEVI void gate_phase(const Params& p, int j) {
  bf16_t* r1 = (bf16_t*)(p.ws + OFF_R1);
  const bf16_t* z = (const bf16_t*)(p.ws + OFF_R0) + R0_Z;
  const float* nw = p.in[13] + j * 128;
  const int tid = TIDX;
  const int lane = tid & 63;
  const int gw = BIDX * 4 + (tid >> 6), nwv = gridDim.x * 4;
  const int half = lane >> 5, l31 = lane & 31;
  const f32x4 w = *(const f32x4*)(nw + l31 * 4);
  for (int t = gw; t < L; t += nwv) {
    u32x2 ov[4], zv[4];
#pragma unroll
    for (int q = 0; q < 4; ++q) {
      const int h = q * 2 + half;
      ov[q] = *(const u32x2*)(r1 + (size_t)t * 3072 + 2048 + h * 128 + l31 * 4);
      zv[q] = *(const u32x2*)(z + (size_t)t * 1024 + h * 128 + l31 * 4);
    }
    float ss[4];
#pragma unroll
    for (int q = 0; q < 4; ++q) {
      const float o0 = bflo(ov[q].x), o1 = bfhi(ov[q].x), o2 = bflo(ov[q].y), o3 = bfhi(ov[q].y);
      ss[q] = o0 * o0 + o1 * o1 + o2 * o2 + o3 * o3;
    }
#pragma unroll
    for (int m = 16; m >= 1; m >>= 1) {
#pragma unroll
      for (int q = 0; q < 4; ++q) ss[q] += __shfl_xor(ss[q], m);
    }
#pragma unroll
    for (int q = 0; q < 4; ++q) {
      const int h = q * 2 + half;
      const float r = rsqrtf(ss[q] * (1.f / 128.f) + 1e-6f);
      const float o[4] = {bflo(ov[q].x), bfhi(ov[q].x), bflo(ov[q].y), bfhi(ov[q].y)};
      const float zz[4] = {bflo(zv[q].x), bfhi(zv[q].x), bflo(zv[q].y), bfhi(zv[q].y)};
      float y[4];
#pragma unroll
      for (int e = 0; e < 4; ++e) y[e] = o[e] * r * w[e] * (zz[e] / (1.f + __expf(-zz[e])));
      *(u32x2*)(r1 + (size_t)t * 3072 + h * 128 + l31 * 4) = u32x2{pack2(y[0], y[1]), pack2(y[2], y[3])};
    }
  }
}


#define XB_TMO      128
#define XB_XCNT(j)  (256  + 64 * (j))
#define XB_XSUB(j)  (1280 + 64 * (j))
#define XB_XGEN(j)  (2304 + 64 * (j))
#define XB_TOP      3328
#define XB_TOPGEN   3392
#define XCD_BAR_WORDS 3456
#define XB_SPIN_CAP (1u << 20)
#define LAS __attribute__((address_space(3)))
DEVI unsigned xb_ld(unsigned* p) { return __hip_atomic_load(p, __ATOMIC_RELAXED, __HIP_MEMORY_SCOPE_AGENT); }
DEVI unsigned xb_add(unsigned* p, unsigned v) { return __hip_atomic_fetch_add(p, v, __ATOMIC_RELAXED, __HIP_MEMORY_SCOPE_AGENT); }
#define XB_SPIN(cond, bar) do { unsigned _sp = 0; while (cond) { __builtin_amdgcn_s_sleep(24); \
    if ((++_sp & 255u) == 0u) { if (xb_ld(&(bar)[XB_TMO])) break; if (_sp > XB_SPIN_CAP) { atomicAdd(&(bar)[XB_TMO], 1u); break; } } } } while (0)
struct XcdBarrier {
  unsigned* bar; unsigned x;
  volatile LAS unsigned* st;
};
DEVI XcdBarrier xcd_barrier_post(unsigned* bar, volatile LAS unsigned* st) {
  XcdBarrier b; b.bar = bar; b.x = xb_xcc_id(); b.st = st;
  if (threadIdx.x == 0) (void)xb_add(&bar[XB_XCNT(b.x)], 1u);
  return b;
}
DEVI void xcd_barrier_complete(unsigned* bar, unsigned x, unsigned& nloc, unsigned& nx) {
  const unsigned G = gridDim.x * gridDim.y * gridDim.z;
  unsigned sum, cnt, mine, sp = 0u;
  for (;;) {
    sum = 0u; cnt = 0u; mine = 0u;
#pragma unroll
    for (unsigned j = 0; j < 16; ++j) { const unsigned c = xb_ld(&bar[XB_XCNT(j)]); sum += c; cnt += (c > 0u) ? 1u : 0u; mine = (j == x) ? c : mine; }
    if (sum == G) break;
    __builtin_amdgcn_s_sleep(1);
    if ((++sp & 255u) == 0u) { if (xb_ld(&bar[XB_TMO])) break; if (sp > XB_SPIN_CAP) { atomicAdd(&bar[XB_TMO], 1u); break; } }
  }
  nloc = mine > 0u ? mine : 1u; nx = cnt > 0u ? cnt : 1u;
}
DEVI void xcd_barrier(const XcdBarrier& b) {
  asm volatile("s_waitcnt vmcnt(0)" ::: "memory");
  __syncthreads();
  if (threadIdx.x == 0) {
    unsigned* bar = b.bar;
    __builtin_amdgcn_s_waitcnt(0);
    unsigned nloc = b.st[0], nx = b.st[1];
    if (nloc == 0u) { xcd_barrier_complete(bar, b.x, nloc, nx); b.st[0] = nloc; b.st[1] = nx; }
    const unsigned old = xb_add(&bar[XB_XSUB(b.x)], 1u);
    const unsigned gen = old / nloc;
    if (old + 1u == (gen + 1u) * nloc) {
      __builtin_amdgcn_fence(__ATOMIC_RELEASE, "agent");
      asm volatile("s_waitcnt vmcnt(0)" ::: "memory");
      const unsigned og = xb_add(&bar[XB_TOP], 1u);
      const unsigned tg = og / nx;
      if (og + 1u == (tg + 1u) * nx) xb_add(&bar[XB_TOPGEN], 1u);
      else XB_SPIN(xb_ld(&bar[XB_TOPGEN]) == tg, bar);
      __builtin_amdgcn_fence(__ATOMIC_ACQUIRE, "agent");
      xb_add(&bar[XB_XGEN(b.x)], 1u);
      asm volatile("s_waitcnt vmcnt(0)" ::: "memory");
    } else {
      XB_SPIN(xb_ld(&bar[XB_XGEN(b.x)]) == gen, bar);
      __builtin_amdgcn_fence(__ATOMIC_ACQUIRE, "agent");
      asm volatile("s_waitcnt vmcnt(0)" ::: "memory");
    }
  }
  __syncthreads();
}

#ifndef ENABLE
#define ENABLE 0xFFFF
#endif
#define EN(bit) if constexpr ((ENABLE >> (bit)) & 1)
__global__ void __launch_bounds__(256, 2) mk(Params p_in, int ph_lo, int ph_hi) {
  extern __shared__ __attribute__((aligned(16))) char smem[];
  __shared__ uint4 sh_misc[2];
  int& s_item = *(int*)&sh_misc[1];
  cg::grid_group grid = cg::this_grid();
  if (threadIdx.x == 0) sh_misc[0] = make_uint4(0u, 0u, 0u, 0u);
  __syncthreads();
  const XcdBarrier xb = xcd_barrier_post((unsigned*)(p_in.ws + OFF_BAR), (volatile LAS unsigned*)&sh_misc[0]);
  grid.sync();
  for (int ph = ph_lo; ph < ph_hi; ++ph) {
    long zoff = 0;
    asm volatile("" : "+s"(zoff));
    Params p;
#pragma unroll
    for (int i = 0; i < 21; ++i) p.in[i] = (const float*)((GLOBAL_AS const float*)(p_in.in[i]));
    p.ws = (char*)((GLOBAL_AS char*)(p_in.ws + zoff));
    p.out = (float*)((GLOBAL_AS float*)(p_in.out + zoff));
    bf16_t* hb = (bf16_t*)(p.ws + OFF_HB);
    bf16_t* wb = (bf16_t*)(p.ws + OFF_WB);
    bf16_t* r0 = (bf16_t*)(p.ws + OFF_R0);
    bf16_t* r1 = (bf16_t*)(p.ws + OFF_R1);
    if (ph == 0) {
      EN(0) { init_phase(p); }
      EN(1) { convert_layer(p, 0, smem); }
    } else {
      const int layer = (ph - 1) / 10, sub = (ph - 1) % 10;
      const int j = layer >> 1;
      const bool even = (layer & 1) == 0;
      if (even && sub >= 3 && sub <= 5) continue;
      if (even) {
        if (sub == 0) {
          EN(2) { gemm_phase(hb, 1024, wb + WB_IN, 1024, 16, smem, EpiEvenIn{r0}); }
        } else if (sub == 1) {
          const float linit = 0.8f - 0.6f * expf(-0.3f * (float)layer);
          EN(4) { attn_phase(p, j, linit, smem, &s_item); }
        } else if (sub == 2) {
          EN(2) { gemm_phase(r1, 1024, wb + WB_OUT, 1024, 8, smem, EpiResid{p}); }
        }
      } else {
        if (sub == 0) {
          EN(2) { gemm_phase(hb, 1024, wb + WB_IN, 1024, 25, smem, EpiOddIn{r0, (float*)(p.ws + OFF_BA)}); }
        } else if (sub == 1) {
          EN(5) { conv_phase(p, j); }
        } else if (sub == 2) {
          EN(6) { for (int it = BIDX; it < NCH * 8; it += gridDim.x) prep_item(p, j, it >> 3, it & 7, smem); }
        } else if (sub == 3) {
          const int nitems = 8 * (8 / NW);
          if ((int)BIDX < nitems) {
            EN(7) { scan_item(p, BIDX & 7, BIDX >> 3, smem); }
          } else {
            EN(2) { gemm_phase(hb, 1024, wb + WB_Z, 1024, 8, smem, EpiZ{r0 + R0_Z}, nitems); }
          }
        } else if (sub == 4) {
          EN(8) { gate_phase(p, j); }
        } else if (sub == 5) {
          EN(2) { gemm_phase(r1, 3072, wb + WB_OUT, 1024, 8, smem, EpiResid{p}); }
        }
      }
      if (sub == 6) {
        EN(9) { ln_phase(p, p.in[17] + layer * 1024, p.in[18] + layer * 1024); }
      } else if (sub == 7) {
        EN(2) { gemm_phase(hb, 1024, wb + WB_W1, 1024, 32, smem, EpiSqRelu{r0}); }
      } else if (sub == 8) {
        EN(2) { gemm_phase(r0, 4096, wb + WB_W2, 4096, 8, smem, EpiResid{p}); }
      } else if (sub == 9) {
        EN(9) { ln_phase(p, p.in[19] + layer * 1024, p.in[20] + layer * 1024); }
        EN(1) { if (layer < 3) convert_layer(p, layer + 1, smem); }
      }
    }
    if (ph + 1 < ph_hi) xcd_barrier(xb);
  }
}

extern "C" void kernel_launch(void* const* d_in, const int* in_sizes, int n_in, void* d_out, int out_size,
                              void* d_ws, size_t ws_size, hipStream_t stream) {
  static int grid_blocks = 0;
  if (!grid_blocks) {
    int dev = 0, cus = 0, per_cu = 0;
    (void)hipGetDevice(&dev);
    (void)hipDeviceGetAttribute(&cus, hipDeviceAttributeMultiprocessorCount, dev);
    (void)hipFuncSetAttribute((const void*)mk, hipFuncAttributeMaxDynamicSharedMemorySize, SMEM_BYTES);
    (void)hipOccupancyMaxActiveBlocksPerMultiprocessor(&per_cu, mk, 256, SMEM_BYTES);
    if (per_cu > 2) per_cu = 2;
    if (per_cu < 1) per_cu = 1;
    grid_blocks = cus * per_cu;
  }
  Params p{};
  for (int i = 0; i < 21; ++i) p.in[i] = (const float*)d_in[i];
  p.out = (float*)d_out;
  p.ws = (char*)d_ws;
  int lo = 0, hi = 41;
  void* args[] = {&p, &lo, &hi};
  (void)hipMemsetAsync((char*)d_ws + OFF_BAR, 0, 16384, stream);
  (void)hipLaunchCooperativeKernel((void*)mk, dim3(grid_blocks), dim3(256), args, SMEM_BYTES, stream);
}
```

```cpp
#include <hip/hip_runtime.h>
#include <hip/hip_cooperative_groups.h>
namespace cg = cooperative_groups;

typedef unsigned short bf16_t;
using bf16x8 = __attribute__((ext_vector_type(8))) short;
using f32x4 = __attribute__((ext_vector_type(4))) float;
using u32x4 = __attribute__((ext_vector_type(4))) unsigned;
using u32x2 = __attribute__((ext_vector_type(2))) unsigned;
typedef __bf16 bf2_t __attribute__((ext_vector_type(2)));
typedef float f2_t __attribute__((ext_vector_type(2)));

#define DEVI __device__ __forceinline__
#define GLOBAL_AS __attribute__((address_space(1)))

DEVI unsigned xb_xcc_id() { return (unsigned)__builtin_amdgcn_s_getreg((3 << 11) | 20) & 0xFu; }
DEVI int opaque_tid() { int t = threadIdx.x; asm volatile("" : "+v"(t)); return t; }
DEVI int opaque_bid() { int b = blockIdx.x; asm volatile("" : "+s"(b)); return b; }
#define TIDX opaque_tid()
#define BIDX opaque_bid()

constexpr int L = 16400;
constexpr int LR = 16512;
constexpr int NMT = 129;
constexpr int NCH = 257;
constexpr float ALPHA = 1.6817928305074290f;
constexpr float LOG2E = 1.4426950408889634f;

constexpr size_t OFF_HB = 0;
constexpr size_t OFF_WB = 33816576;
constexpr size_t OFF_METAH = 61341696;
constexpr size_t OFF_MISC = 61407232;
constexpr size_t OFF_BA = 61411328;
constexpr size_t OFF_R0 = 62468096;
constexpr size_t OFF_R1 = 163917824;
constexpr size_t OFF_BAR = 265367552;
constexpr size_t WB_IN = 0, WB_Z = 3276800, WB_OUT = 4325376, WB_W1 = 5373952, WB_W2 = 9568256;
constexpr size_t R0_Q = 0, R0_K = 8454144, R0_VT = 16908288, R0_U = 25362432;
constexpr size_t R0_KT = 0, R0_QK = 16842752, R0_G = 25264128, R0_Z = 26100000;

constexpr int SMEM_BYTES = 73728 + 1024;

struct Params {
  const float* in[21];
  float* out;
  char* ws;
};

DEVI unsigned pack2(float a, float b) {
  f2_t v = {a, b};
  bf2_t r = __builtin_convertvector(v, bf2_t);
  return __builtin_bit_cast(unsigned, r);
}
DEVI bf16_t f2bf(float a) { return (bf16_t)(pack2(a, 0.f) & 0xffff); }
DEVI float bf2f(bf16_t b) { return __uint_as_float(((unsigned)b) << 16); }
DEVI float bflo(unsigned u) { return __uint_as_float(u << 16); }
DEVI float bfhi(unsigned u) { return __uint_as_float(u & 0xffff0000u); }

DEVI float* hfrow(const Params& p, int t) {
  return t < 16 ? (float*)(p.ws + OFF_METAH) + t * 1024 : p.out + (size_t)(t - 16) * 1024;
}
DEVI float wave_sum(float v) {
#pragma unroll
  for (int m = 32; m >= 1; m >>= 1) v += __shfl_xor(v, m);
  return v;
}
DEVI bf16x8 mk8(u32x2 a, u32x2 b) {
  u32x4 r = {a.x, a.y, b.x, b.y};
  return __builtin_bit_cast(bf16x8, r);
}
DEVI bf16x8 pack8(f32x4 a, f32x4 b) {
  u32x4 r = {pack2(a[0], a[1]), pack2(a[2], a[3]), pack2(b[0], b[1]), pack2(b[2], b[3])};
  return __builtin_bit_cast(bf16x8, r);
}
DEVI size_t wfm(int n, int k, int K) {
  return ((size_t)(n >> 4) * (K >> 5) + (k >> 5)) * 512 + ((((k >> 3) & 3) << 4) + (n & 15)) * 8 + (k & 7);
}
#define MFMA16(a, b, c) __builtin_amdgcn_mfma_f32_16x16x32_bf16((a), (b), (c), 0, 0, 0)

template <class Epi>
DEVI void gemm_tile(const bf16_t* __restrict__ A, int lda, const bf16_t* __restrict__ Bt, int K,
                    int m0, int n0, char* smem, Epi epi) {
  const int tid = TIDX, lane = tid & 63, wave = tid >> 6;
  const int wm = wave >> 1, wn = wave & 1, l15 = lane & 15, quad = lane >> 4;
  f32x4 acc[4][4];
#pragma unroll
  for (int i = 0; i < 4; ++i)
#pragma unroll
    for (int j = 0; j < 4; ++j) acc[i][j] = f32x4{0.f, 0.f, 0.f, 0.f};
  const int lrow = tid >> 3, lkc = tid & 7;
  const bf16_t* ag = A + (size_t)(m0 + lrow) * lda + lkc * 8;
  const bf16_t* bg = Bt + (size_t)(n0 + lrow) * K + lkc * 8;
  u32x4 ra[4], rb[4];
#pragma unroll
  for (int i = 0; i < 4; ++i) {
    ra[i] = *(const u32x4*)(ag + (size_t)(i * 32) * lda);
    rb[i] = *(const u32x4*)(bg + (size_t)(i * 32) * K);
  }
  const int lds_w = lrow * 128 + ((lkc ^ (lrow & 7)) << 4);
#pragma unroll
  for (int i = 0; i < 4; ++i) {
    *(u32x4*)(smem + lds_w + i * 4096) = ra[i];
    *(u32x4*)(smem + 16384 + lds_w + i * 4096) = rb[i];
  }
  __syncthreads();
  const int nk = K >> 6;
  const int sw = (quad ^ (l15 & 7)) << 4;
  const int a_rd = (wm * 64 + l15) * 128 + sw;
  const int b_rd = 16384 + (wn * 64 + l15) * 128 + sw;
  for (int kt = 0; kt < nk; ++kt) {
    const int buf = (kt & 1) * 32768;
    if (kt + 1 < nk) {
#pragma unroll
      for (int i = 0; i < 4; ++i) {
        ra[i] = *(const u32x4*)(ag + (size_t)(i * 32) * lda + (kt + 1) * 64);
        rb[i] = *(const u32x4*)(bg + (size_t)(i * 32) * K + (kt + 1) * 64);
      }
    }
#pragma unroll
    for (int ks = 0; ks < 2; ++ks) {
      bf16x8 af[4], bf[4];
#pragma unroll
      for (int i = 0; i < 4; ++i) {
        af[i] = *(const bf16x8*)(smem + buf + ((a_rd + i * 2048) ^ (ks * 64)));
        bf[i] = *(const bf16x8*)(smem + buf + ((b_rd + i * 2048) ^ (ks * 64)));
      }
#pragma unroll
      for (int mi = 0; mi < 4; ++mi)
#pragma unroll
        for (int ni = 0; ni < 4; ++ni) acc[mi][ni] = MFMA16(bf[ni], af[mi], acc[mi][ni]);
    }
    if (kt + 1 < nk) {
      const int nb = ((kt + 1) & 1) * 32768;
#pragma unroll
      for (int i = 0; i < 4; ++i) {
        *(u32x4*)(smem + nb + lds_w + i * 4096) = ra[i];
        *(u32x4*)(smem + nb + 16384 + lds_w + i * 4096) = rb[i];
      }
    }
    __syncthreads();
  }
#pragma unroll
  for (int mi = 0; mi < 4; ++mi)
#pragma unroll
    for (int ni = 0; ni < 4; ++ni)
      epi(m0 + wm * 64 + mi * 16 + l15, n0 + wn * 64 + ni * 16 + quad * 4, acc[mi][ni]);
}

template <class Epi>
DEVI void gemm_tile256(const bf16_t* __restrict__ A, int lda, const bf16_t* __restrict__ Bt, int K,
                       int m0, int n0, char* smem, Epi epi) {
  const int tid = TIDX, lane = tid & 63, wave = tid >> 6;
  const int wm = wave >> 1, wn = wave & 1, l15 = lane & 15, quad = lane >> 4;
  f32x4 acc[8][4];
#pragma unroll
  for (int i = 0; i < 8; ++i)
#pragma unroll
    for (int j = 0; j < 4; ++j) acc[i][j] = f32x4{0.f, 0.f, 0.f, 0.f};
  const int lrow = tid >> 3, lkc = tid & 7;
  const bf16_t* ag = A + (size_t)(m0 + lrow) * lda + lkc * 8;
  const bf16_t* bg = Bt + (size_t)(n0 + lrow) * K + lkc * 8;
  u32x4 ra[8], rb[4];
  auto gload = [&](int kt) {
#pragma unroll
    for (int i = 0; i < 8; ++i) ra[i] = *(const u32x4*)(ag + (size_t)(i * 32) * lda + kt * 64);
#pragma unroll
    for (int i = 0; i < 4; ++i) rb[i] = *(const u32x4*)(bg + (size_t)(i * 32) * K + kt * 64);
  };
  const int lds_w = lrow * 128 + ((lkc ^ (lrow & 7)) << 4);
  const int nk = K >> 6;
  const int sw = (quad ^ (l15 & 7)) << 4;
  const int a_rd = (wm * 128 + l15) * 128 + sw;
  const int b_rd = 32768 + (wn * 64 + l15) * 128 + sw;
  gload(0);
  for (int kt = 0; kt < nk; ++kt) {
#pragma unroll
    for (int i = 0; i < 8; ++i) *(u32x4*)(smem + lds_w + i * 4096) = ra[i];
#pragma unroll
    for (int i = 0; i < 4; ++i) *(u32x4*)(smem + 32768 + lds_w + i * 4096) = rb[i];
    __syncthreads();
    if (kt + 1 < nk) gload(kt + 1);
#pragma unroll
    for (int ks = 0; ks < 2; ++ks) {
      bf16x8 af[8], bf[4];
#pragma unroll
      for (int i = 0; i < 4; ++i) bf[i] = *(const bf16x8*)(smem + ((b_rd + i * 2048) ^ (ks * 64)));
#pragma unroll
      for (int i = 0; i < 8; ++i) af[i] = *(const bf16x8*)(smem + ((a_rd + i * 2048) ^ (ks * 64)));
#pragma unroll
      for (int mi = 0; mi < 8; ++mi)
#pragma unroll
        for (int ni = 0; ni < 4; ++ni) acc[mi][ni] = MFMA16(bf[ni], af[mi], acc[mi][ni]);
    }
    __syncthreads();
  }
#pragma unroll
  for (int mi = 0; mi < 8; ++mi)
#pragma unroll
    for (int ni = 0; ni < 4; ++ni)
      epi(m0 + wm * 128 + mi * 16 + l15, n0 + wn * 64 + ni * 16 + quad * 4, acc[mi][ni]);
}

template <class Epi>
DEVI void gemm_tile256b(const bf16_t* __restrict__ A, int lda, const bf16_t* __restrict__ Bt, int K,
                        int m0, int n0, char* smem, Epi epi) {
  const int tid = TIDX, lane = tid & 63, wave = tid >> 6;
  const int wm = wave >> 1, wn = wave & 1, l15 = lane & 15, quad = lane >> 4;
  f32x4 acc[8][4];
#pragma unroll
  for (int i = 0; i < 8; ++i)
#pragma unroll
    for (int j = 0; j < 4; ++j) acc[i][j] = f32x4{0.f, 0.f, 0.f, 0.f};
  const int lrow = tid >> 3, lkc = tid & 7;
  const bf16_t* ag = A + (size_t)(m0 + lrow) * lda + lkc * 8;
  const int kb32 = K >> 5;
  const bf16_t* bp = Bt + ((size_t)((n0 + wn * 64) >> 4) * kb32) * 512 + lane * 8;
  u32x4 ra[8];
  bf16x8 b0[4], b1[4];
  const int lds_w = lrow * 128 + ((lkc ^ (lrow & 7)) << 4);
  const int nk = K >> 6;
  const int sw = (quad ^ (l15 & 7)) << 4;
  const int a_rd = (wm * 128 + l15) * 128 + sw;
#pragma unroll
  for (int i = 0; i < 8; ++i) ra[i] = *(const u32x4*)(ag + (size_t)(i * 32) * lda);
#pragma unroll
  for (int i = 0; i < 4; ++i) b0[i] = *(const bf16x8*)(bp + ((size_t)i * kb32) * 512);
#pragma unroll
  for (int i = 0; i < 8; ++i) *(u32x4*)(smem + lds_w + i * 4096) = ra[i];
  __syncthreads();
  for (int kt = 0; kt < nk; ++kt) {
    const char* base = smem + (kt & 1) * 32768;
    const bool more = kt + 1 < nk;
    if (more) {
#pragma unroll
      for (int i = 0; i < 8; ++i) ra[i] = *(const u32x4*)(ag + (size_t)(i * 32) * lda + (kt + 1) * 64);
    }
#pragma unroll
    for (int i = 0; i < 4; ++i) b1[i] = *(const bf16x8*)(bp + ((size_t)i * kb32 + kt * 2 + 1) * 512);
    {
      bf16x8 af[8];
#pragma unroll
      for (int i = 0; i < 8; ++i) af[i] = *(const bf16x8*)(base + a_rd + i * 2048);
#pragma unroll
      for (int mi = 0; mi < 8; ++mi)
#pragma unroll
        for (int ni = 0; ni < 4; ++ni) acc[mi][ni] = MFMA16(b0[ni], af[mi], acc[mi][ni]);
    }
    if (more) {
#pragma unroll
      for (int i = 0; i < 4; ++i) b0[i] = *(const bf16x8*)(bp + ((size_t)i * kb32 + kt * 2 + 2) * 512);
    }
    {
      bf16x8 af[8];
#pragma unroll
      for (int i = 0; i < 8; ++i) af[i] = *(const bf16x8*)(base + ((a_rd + i * 2048) ^ 64));
#pragma unroll
      for (int mi = 0; mi < 8; ++mi)
#pragma unroll
        for (int ni = 0; ni < 4; ++ni) acc[mi][ni] = MFMA16(b1[ni], af[mi], acc[mi][ni]);
    }
    if (more) {
      char* nb = smem + ((kt + 1) & 1) * 32768 + lds_w;
#pragma unroll
      for (int i = 0; i < 8; ++i) *(u32x4*)(nb + i * 4096) = ra[i];
    }
    __syncthreads();
  }
#pragma unroll
  for (int mi = 0; mi < 8; ++mi)
#pragma unroll
    for (int ni = 0; ni < 4; ++ni)
      epi(m0 + wm * 128 + mi * 16 + l15, n0 + wn * 64 + ni * 16 + quad * 4, acc[mi][ni]);
}

template <class Epi>
DEVI void gemm_tail_tile(const bf16_t* __restrict__ A, int lda, const bf16_t* __restrict__ Bt, int K, int n0,
                         char* smem, Epi epi) {
  const int tid = TIDX, lane = tid & 63, wave = tid >> 6, l15 = lane & 15, quad = lane >> 4;
  constexpr int M0 = 16384;
  f32x4 acc[8];
#pragma unroll
  for (int i = 0; i < 8; ++i) acc[i] = f32x4{0.f, 0.f, 0.f, 0.f};
  const int kq = K >> 2;
  const bf16_t* ag = A + (size_t)(M0 + l15) * lda + wave * kq + quad * 8;
  const int kb32 = K >> 5;
  const bf16_t* bg = Bt + ((size_t)(n0 >> 4) * kb32 + ((wave * kq) >> 5)) * 512 + lane * 8;
  bf16x8 a0, a1, b0[8], b1[8];
  auto tload = [&](bf16x8& a, bf16x8 (&b)[8], int k) {
    a = *(const bf16x8*)(ag + k);
#pragma unroll
    for (int nt = 0; nt < 8; ++nt) b[nt] = *(const bf16x8*)(bg + ((size_t)nt * kb32 + (k >> 5)) * 512);
  };
  tload(a0, b0, 0);
  tload(a1, b1, 32);
  for (int k = 0; k < kq; k += 64) {
#pragma unroll
    for (int nt = 0; nt < 8; ++nt) acc[nt] = MFMA16(b0[nt], a0, acc[nt]);
    if (k + 64 < kq) tload(a0, b0, k + 64);
#pragma unroll
    for (int nt = 0; nt < 8; ++nt) acc[nt] = MFMA16(b1[nt], a1, acc[nt]);
    if (k + 96 < kq) tload(a1, b1, k + 96);
  }
  f32x4* red = (f32x4*)smem;
#pragma unroll
  for (int nt = 0; nt < 8; ++nt) red[(wave * 8 + nt) * 64 + lane] = acc[nt];
  __syncthreads();
#pragma unroll
  for (int q = 0; q < 2; ++q) {
    const int nt = wave * 2 + q;
    f32x4 v = red[(0 * 8 + nt) * 64 + lane] + red[(1 * 8 + nt) * 64 + lane] + red[(2 * 8 + nt) * 64 + lane] +
              red[(3 * 8 + nt) * 64 + lane];
    epi(M0 + l15, n0 + nt * 16 + quad * 4, v);
  }
  __syncthreads();
}

template <class Epi>
DEVI void gemm_phase(const bf16_t* A, int lda, const bf16_t* Bt, int K, int nnt, char* smem, Epi epi,
                     int skip = 0) {
  const int nmain = 64 * nnt, ntiles = nmain + nnt;
  const int nb = gridDim.x - skip;
  const int b = BIDX - skip;
  const bool xmap = (skip == 0) && ((nnt & 7) == 0) && ((nb & 63) == 0);
  const int q = xmap ? (b & 7) * (nb >> 3) + (b >> 3) : b;
  for (int t0 = 0; t0 < ntiles; t0 += nb) {
    const int t = t0 + q;
    if (t >= ntiles) break;
    if (t < nmain) {
      int mt, nt;
      if (xmap) {
        const int s_ = t >> 6, w_ = t & 63, spr = nnt >> 3;
        const int sm = s_ / spr, sn = s_ - sm * spr;
        mt = sm * 8 + (w_ >> 3);
        nt = sn * 8 + (w_ & 7);
      } else {
        mt = t / nnt;
        nt = t - mt * nnt;
      }
      gemm_tile256b(A, lda, Bt, K, mt * 256, nt * 128, smem, epi);
    } else {
      gemm_tail_tile(A, lda, Bt, K, (t - nmain) * 128, smem, epi);
    }
  }
}

struct EpiEvenIn {
  bf16_t* r0;
  DEVI void operator()(int m, int n, f32x4 v) const {
    if (n < 1024) {
      if (m >= L) return;
      const bool isq = n < 512;
      const int nn = n & 511;
      const int h = nn >> 7, c = (nn >> 6) & 1, d = nn & 63;
      const float s = isq ? (0.125f * LOG2E) : 1.0f;
      bf16_t* dst = isq ? r0 + R0_Q + ((size_t)(h * 2 + c) * LR + m) * 64 + d
                        : r0 + R0_K + (size_t)(h * 2 + c) * LR * 64 + wfm(m, d, 64);
      *(u32x2*)dst = u32x2{pack2(v[0] * s, v[1] * s), pack2(v[2] * s, v[3] * s)};
    } else if (n < 1536) {
      const int nn = n - 1024;
      bf16_t* dst = r0 + R0_VT + (size_t)nn * LR + m;
      const bool ok = m < L;
#pragma unroll
      for (int i = 0; i < 4; ++i) {
        dst[(size_t)i * LR] = ok ? f2bf(v[i]) : (bf16_t)0;
        if (m >= 16384) {
          dst[(size_t)i * LR + 16] = 0;
          dst[(size_t)i * LR + 32] = 0;
          dst[(size_t)i * LR + 48] = 0;
        }
      }
    } else {
      if (m >= L) return;
      bf16_t* dst = r0 + R0_U + (size_t)m * 512 + (n - 1536);
      *(u32x2*)dst = u32x2{pack2(v[0], v[1]), pack2(v[2], v[3])};
    }
  }
};
struct EpiResid {
  Params p;
  bool first;
  DEVI void operator()(int m, int n, f32x4 v) const {
    if (m >= L) return;
    float* h = hfrow(p, m) + n;
    const float* src = (first && m >= 16) ? p.in[0] + (size_t)(m - 16) * 1024 + n : h;
    f32x4 o = *(const f32x4*)src;
    o = o * ALPHA + v;
    *(f32x4*)h = o;
  }
};
struct EpiOddIn {
  bf16_t* raw;
  float* ba;
  DEVI void operator()(int m, int n, f32x4 v) const {
    if (m >= L) return;
    if (n < 3072) {
      *(u32x2*)(raw + (size_t)m * 3072 + n) = u32x2{pack2(v[0], v[1]), pack2(v[2], v[3])};
    } else if (n < 3088) {
      *(f32x4*)(ba + (size_t)m * 16 + (n - 3072)) = v;
    }
  }
};
struct EpiZ {
  bf16_t* z;
  DEVI void operator()(int m, int n, f32x4 v) const {
    if (m >= L) return;
    *(u32x2*)(z + (size_t)m * 1024 + n) = u32x2{pack2(v[0], v[1]), pack2(v[2], v[3])};
  }
};
struct EpiSqRelu {
  bf16_t* hid;
  DEVI void operator()(int m, int n, f32x4 v) const {
    if (m >= L) return;
    float a = fmaxf(v[0], 0.f), b = fmaxf(v[1], 0.f), c = fmaxf(v[2], 0.f), d = fmaxf(v[3], 0.f);
    *(u32x2*)(hid + (size_t)m * 4096 + n) = u32x2{pack2(a * a, b * b), pack2(c * c, d * d)};
  }
};

DEVI void tconv_seg(const float* src, int ld, int krows, int c0, int ncols, int ndst, bf16_t* dst, int dld,
                    char* smem) {
  float* tile = (float*)smem;
  const int tid = TIDX;
  const int nkt = krows >> 6, nnt = (ndst + 63) >> 6;
  const int lr = tid >> 4, lc = (tid & 15) * 4;
  const int kp = tid & 31, wn = tid >> 5;
  for (int t = BIDX; t < nkt * nnt; t += gridDim.x) {
    const int kt = t % nkt, nt = t / nkt;
    const int k0 = kt * 64, n0 = nt * 64;
#pragma unroll
    for (int i = 0; i < 4; ++i) {
      const int r = i * 16 + lr;
      f32x4 v = f32x4{0.f, 0.f, 0.f, 0.f};
      if (n0 + lc < ncols) v = *(const f32x4*)(src + (size_t)(k0 + r) * ld + c0 + n0 + lc);
      tile[r * 65 + lc + 0] = v[0];
      tile[r * 65 + lc + 1] = v[1];
      tile[r * 65 + lc + 2] = v[2];
      tile[r * 65 + lc + 3] = v[3];
    }
    __syncthreads();
#pragma unroll
    for (int i = 0; i < 8; ++i) {
      const int rn = i * 8 + wn;
      if (n0 + rn < ndst)
        *(unsigned*)(dst + wfm(n0 + rn, k0 + 2 * kp, dld)) = pack2(tile[(2 * kp) * 65 + rn], tile[(2 * kp + 1) * 65 + rn]);
    }
    __syncthreads();
  }
}

DEVI void convert_layer(const Params& p, int layer, char* smem) {
  bf16_t* wb = (bf16_t*)(p.ws + OFF_WB);
  const int j = layer >> 1;
  if ((layer & 1) == 0) {
    tconv_seg(p.in[3] + (size_t)j * 1024 * 2048, 2048, 1024, 0, 2048, 2048, wb + WB_IN, 1024, smem);
    tconv_seg(p.in[8] + (size_t)j * 1024 * 1024, 1024, 512, 0, 1024, 1024, wb + WB_OUT, 1024, smem);
    const float* pw = p.in[6] + (size_t)j * 4 * 128 * 128;
    const float* ps = p.in[7] + (size_t)j * 512;
    const float* wo = p.in[8] + (size_t)j * 1024 * 1024;
    {
      const int tid = TIDX;
      for (int item = BIDX; item < 512; item += gridDim.x) {
        const int g = item >> 7, c = item & 127;
        const float* pwr = pw + ((size_t)g * 128 + c) * 128;
        const float* wor = wo + (size_t)(512 + g * 128) * 1024 + tid * 4;
        f32x4 acc = f32x4{0.f, 0.f, 0.f, 0.f};
#pragma unroll 8
        for (int d = 0; d < 128; ++d) {
          const float a = pwr[d] * ps[g * 128 + d];
          const f32x4 w4 = *(const f32x4*)(wor + (size_t)d * 1024);
          acc = acc + w4 * a;
        }
#pragma unroll
        for (int e = 0; e < 4; ++e) wb[WB_OUT + wfm(tid * 4 + e, 512 + item, 1024)] = f2bf(acc[e]);
      }
    }
  } else {
    const float* wi = p.in[9] + (size_t)j * 1024 * 4112;
    tconv_seg(wi, 4112, 1024, 0, 3072, 3072, wb + WB_IN, 1024, smem);
    tconv_seg(wi, 4112, 1024, 4096, 16, 128, wb + WB_IN + (size_t)3072 * 1024, 1024, smem);
    tconv_seg(wi, 4112, 1024, 3072, 1024, 1024, wb + WB_Z, 1024, smem);
    tconv_seg(p.in[14] + (size_t)j * 1024 * 1024, 1024, 1024, 0, 1024, 1024, wb + WB_OUT, 1024, smem);
  }
  tconv_seg(p.in[15] + (size_t)layer * 1024 * 4096, 4096, 1024, 0, 4096, 4096, wb + WB_W1, 1024, smem);
  tconv_seg(p.in[16] + (size_t)layer * 4096 * 1024, 1024, 4096, 0, 1024, 1024, wb + WB_W2, 4096, smem);
}

DEVI void init_phase(const Params& p) {
  const int gt = BIDX * 256 + TIDX, nth = gridDim.x * 256;
  if (gt < 64) ((int*)(p.ws + OFF_MISC))[gt] = 0;
  bf16_t* hb = (bf16_t*)(p.ws + OFF_HB);
  for (int idx = gt; idx < L * 256; idx += nth) {
    const int t = idx >> 8, c = (idx & 255) * 4;
    f32x4 v = (t < 16) ? *(const f32x4*)(p.in[1] + t * 1024 + c) : *(const f32x4*)(p.in[0] + (size_t)(t - 16) * 1024 + c);
    if (t < 16) *(f32x4*)(hfrow(p, t) + c) = v;
    *(u32x2*)(hb + (size_t)t * 1024 + c) = u32x2{pack2(v[0], v[1]), pack2(v[2], v[3])};
  }
}

DEVI void ln_phase(const Params& p, const float* g, const float* b, bool whb = true) {
  const int tid = TIDX;
  const int lane = tid & 63;
  const int gw = BIDX * 4 + (tid >> 6), nw = gridDim.x * 4;
  bf16_t* hb = (bf16_t*)(p.ws + OFF_HB);
  for (int t0 = gw * 4; t0 < L; t0 += nw * 4) {
    f32x4 v[4][4];
    float* h[4];
#pragma unroll
    for (int r = 0; r < 4; ++r) {
      h[r] = hfrow(p, t0 + r);
#pragma unroll
      for (int i = 0; i < 4; ++i) v[r][i] = *(const f32x4*)(h[r] + i * 256 + lane * 4);
    }
    float s[4], q[4];
#pragma unroll
    for (int r = 0; r < 4; ++r) {
      s[r] = 0.f;
#pragma unroll
      for (int i = 0; i < 4; ++i) s[r] += v[r][i][0] + v[r][i][1] + v[r][i][2] + v[r][i][3];
    }
#pragma unroll
    for (int m = 32; m >= 1; m >>= 1) {
#pragma unroll
      for (int r = 0; r < 4; ++r) s[r] += __shfl_xor(s[r], m);
    }
#pragma unroll
    for (int r = 0; r < 4; ++r) {
      const float mu = s[r] * (1.f / 1024.f);
      q[r] = 0.f;
#pragma unroll
      for (int i = 0; i < 4; ++i) {
        v[r][i] = v[r][i] - mu;
        q[r] += v[r][i][0] * v[r][i][0] + v[r][i][1] * v[r][i][1] + v[r][i][2] * v[r][i][2] + v[r][i][3] * v[r][i][3];
      }
    }
#pragma unroll
    for (int m = 32; m >= 1; m >>= 1) {
#pragma unroll
      for (int r = 0; r < 4; ++r) q[r] += __shfl_xor(q[r], m);
    }
#pragma unroll
    for (int i = 0; i < 4; ++i) {
      const f32x4 gg = *(const f32x4*)(g + i * 256 + lane * 4);
      const f32x4 bb = *(const f32x4*)(b + i * 256 + lane * 4);
#pragma unroll
      for (int r = 0; r < 4; ++r) {
        const float rstd = rsqrtf(q[r] * (1.f / 1024.f) + 1e-5f);
        f32x4 y = v[r][i] * rstd * gg + bb;
        *(f32x4*)(h[r] + i * 256 + lane * 4) = y;
        if (whb) *(u32x2*)(hb + (size_t)(t0 + r) * 1024 + i * 256 + lane * 4) = u32x2{pack2(y[0], y[1]), pack2(y[2], y[3])};
      }
    }
  }
}

constexpr int POOL_CHUNK = 2048, POOL_NCHUNK = (L * 64 + POOL_CHUNK - 1) / POOL_CHUNK;
DEVI void pool_chunk(const Params& p, int chunk) {
  const bf16_t* U = (const bf16_t*)(p.ws + OFF_R0) + R0_U;
  bf16_t* cat = (bf16_t*)(p.ws + OFF_R1);
  const int tid_ = TIDX;
  const int lim = min((chunk + 1) * POOL_CHUNK, L * 64);
  for (int idx = chunk * POOL_CHUNK + tid_; idx < lim; idx += 256) {
    const int t = idx >> 6, cc = idx & 63, g = cc >> 4;
    const int win = 2 << g;
    const int cnt = min(t + 1, win);
    float s[8];
#pragma unroll
    for (int e = 0; e < 8; ++e) s[e] = 0.f;
    u32x4 self = u32x4{0, 0, 0, 0};
    u32x4 tv[16];
#pragma unroll
    for (int k = 0; k < 16; ++k) {
      tv[k] = u32x4{0, 0, 0, 0};
      if (k < cnt) tv[k] = *(const u32x4*)(U + (size_t)(t - k) * 512 + cc * 8);
    }
    self = tv[0];
#pragma unroll
    for (int k = 0; k < 16; ++k) {
#pragma unroll
      for (int e = 0; e < 4; ++e) {
        s[2 * e] += bflo(tv[k][e]);
        s[2 * e + 1] += bfhi(tv[k][e]);
      }
    }
    const float inv = 1.f / (float)cnt;
    u32x4 o;
#pragma unroll
    for (int e = 0; e < 4; ++e) o[e] = pack2(s[2 * e] * inv - bflo(self[e]), s[2 * e + 1] * inv - bfhi(self[e]));
    *(u32x4*)(cat + (size_t)t * 1024 + 512 + cc * 8) = o;
  }
}

DEVI void attn_item(const Params& p, int j, int h, int qt, float lam, float one_m_linit, char* smem) {
  const int tid = TIDX, lane = tid & 63, wave = tid >> 6;
  const int rg = wave & 1, c = wave >> 1, l15 = lane & 15, quad = lane >> 4;
  const bf16_t* r0 = (const bf16_t*)(p.ws + OFF_R0);
  const bf16_t* Qg = r0 + R0_Q + (size_t)(h * 2 + c) * LR * 64;
  const bf16_t* Kfm = r0 + R0_K + (size_t)(h * 2 + c) * LR * 64 + lane * 8;
  const bf16_t* Vg = r0 + R0_VT + (size_t)(h * 128) * LR;
  const float* tbl = (const float*)(smem + 73728);
  const int q0 = qt * 64;
  const int qw = q0 + rg * 32;
  bf16x8 qf[2][2];
#pragma unroll
  for (int qi = 0; qi < 2; ++qi)
#pragma unroll
    for (int ks = 0; ks < 2; ++ks)
      qf[qi][ks] = *(const bf16x8*)(Qg + (size_t)(qw + qi * 16 + l15) * 64 + ks * 32 + quad * 8);
  f32x4 oacc[2][8];
#pragma unroll
  for (int qi = 0; qi < 2; ++qi)
#pragma unroll
    for (int d = 0; d < 8; ++d) oacc[qi][d] = f32x4{0.f, 0.f, 0.f, 0.f};
  float mrun[2] = {0.f, 0.f};
  f32x4 lacc[2] = {f32x4{0.f, 0.f, 0.f, 0.f}, f32x4{0.f, 0.f, 0.f, 0.f}};
  const bf16x8 ones = {16256, 16256, 16256, 16256, 16256, 16256, 16256, 16256};
  const int nkt = qt + 1;
  const int krow = tid >> 3, kkc = tid & 7;
  u32x4 rv[4];
  auto gload = [&](int kt) {
    const int k0 = kt * 64;
#pragma unroll
    for (int i = 0; i < 4; ++i) rv[i] = *(const u32x4*)(Vg + (size_t)(krow + i * 32) * LR + k0 + kkc * 8);
  };
  auto lstore = [&](int buf) {
    char* b = smem + buf * 34816;
#pragma unroll
    for (int i = 0; i < 4; ++i) *(u32x4*)(b + 16384 + (krow + i * 32) * 144 + kkc * 16) = rv[i];
  };
  bf16x8 kf[4][2];
  auto kload = [&](int kt) {
#pragma unroll
    for (int ki = 0; ki < 4; ++ki)
#pragma unroll
      for (int ks = 0; ks < 2; ++ks) kf[ki][ks] = *(const bf16x8*)(Kfm + ((size_t)((kt * 4 + ki) * 2 + ks)) * 512);
  };
  gload(0);
  kload(0);
  lstore(0);
  __syncthreads();
  for (int kt = 0; kt < nkt; ++kt) {
    const char* b = smem + (kt & 1) * 34816;
    if (kt + 1 < nkt) gload(kt + 1);
    const int k0 = kt * 64;
    if (k0 <= qw + 31) {
      f32x4 st[2][4];
#pragma unroll
      for (int qi = 0; qi < 2; ++qi)
#pragma unroll
        for (int ki = 0; ki < 4; ++ki) st[qi][ki] = f32x4{-mrun[qi], -mrun[qi], -mrun[qi], -mrun[qi]};
      const char* vb = b + 16384;
      bf16x8 vf[2][4];
      auto vload = [&](int g, int slot) {
#pragma unroll
        for (int dd = 0; dd < 2; ++dd)
#pragma unroll
          for (int s2 = 0; s2 < 2; ++s2) {
            const char* a = vb + ((g * 2 + dd) * 16 + l15) * 144 + s2 * 64 + quad * 8;
            vf[slot][dd * 2 + s2] = mk8(*(const u32x2*)a, *(const u32x2*)(a + 32));
          }
      };
      __builtin_amdgcn_s_setprio(2);
#pragma unroll
      for (int ki = 0; ki < 4; ++ki)
#pragma unroll
        for (int ks = 0; ks < 2; ++ks) {
#pragma unroll
          for (int qi = 0; qi < 2; ++qi) st[qi][ki] = MFMA16(kf[ki][ks], qf[qi][ks], st[qi][ki]);
        }
      __builtin_amdgcn_s_setprio(0);
      if (kt + 1 < nkt) kload(kt + 1);
      __builtin_amdgcn_sched_barrier(0);
      const bool far = (qw - (k0 + 63)) >= 128;
      const bool first = (kt == 0);
#pragma unroll
      for (int qi = 0; qi < 2; ++qi) {
        if (!far) {
          const int qpos = qw + qi * 16 + l15;
#pragma unroll
          for (int ki = 0; ki < 4; ++ki)
#pragma unroll
            for (int jj = 0; jj < 4; ++jj) {
              const int n = qpos - (k0 + ki * 16 + quad * 4 + jj);
              st[qi][ki][jj] = (n >= 0) ? st[qi][ki][jj] + tbl[min(n, 128)] : -1e30f;
            }
        }
        float tmax = st[qi][0][0];
#pragma unroll
        for (int ki = 0; ki < 4; ++ki)
#pragma unroll
          for (int jj = 0; jj < 4; jj += 2) tmax = fmaxf(fmaxf(tmax, st[qi][ki][jj]), st[qi][ki][jj + 1]);
        tmax = fmaxf(tmax, __shfl_xor(tmax, 16));
        tmax = fmaxf(tmax, __shfl_xor(tmax, 32));
        if (first || __any(tmax > 8.0f)) {
          const float dm = first ? tmax : fmaxf(tmax, 0.f);
          const float alpha = __builtin_amdgcn_exp2f(-dm);
          mrun[qi] += dm;
          lacc[qi] = lacc[qi] * alpha;
#pragma unroll
          for (int d = 0; d < 8; ++d) oacc[qi][d] = oacc[qi][d] * alpha;
#pragma unroll
          for (int ki = 0; ki < 4; ++ki) st[qi][ki] = st[qi][ki] - dm;
        }
#pragma unroll
        for (int ki = 0; ki < 4; ++ki)
#pragma unroll
          for (int jj = 0; jj < 4; ++jj) st[qi][ki][jj] = __builtin_amdgcn_exp2f(st[qi][ki][jj]);
      }
      vload(0, 0);
      bf16x8 pb[2][2];
#pragma unroll
      for (int qi = 0; qi < 2; ++qi)
#pragma unroll
        for (int s2 = 0; s2 < 2; ++s2) pb[qi][s2] = pack8(st[qi][2 * s2], st[qi][2 * s2 + 1]);
      __builtin_amdgcn_s_setprio(2);
#pragma unroll
      for (int qi = 0; qi < 2; ++qi)
#pragma unroll
        for (int s2 = 0; s2 < 2; ++s2) lacc[qi] = MFMA16(ones, pb[qi][s2], lacc[qi]);
#pragma unroll
      for (int g = 0; g < 4; ++g) {
        if (g < 3) vload(g + 1, (g + 1) & 1);
#pragma unroll
        for (int dd = 0; dd < 2; ++dd)
#pragma unroll
          for (int s2 = 0; s2 < 2; ++s2)
#pragma unroll
            for (int qi = 0; qi < 2; ++qi)
              oacc[qi][g * 2 + dd] = MFMA16(vf[g & 1][dd * 2 + s2], pb[qi][s2], oacc[qi][g * 2 + dd]);
        __builtin_amdgcn_sched_barrier(0);
      }
      __builtin_amdgcn_s_setprio(0);
    }
    if (kt + 1 < nkt) lstore((kt + 1) & 1);
    __syncthreads();
  }
#pragma unroll
  for (int qi = 0; qi < 2; ++qi) {
    const float inv = 1.f / lacc[qi][0];
#pragma unroll
    for (int d = 0; d < 8; ++d) oacc[qi][d] = oacc[qi][d] * inv;
  }
  f32x4* xb = (f32x4*)smem;
  if (c == 1) {
#pragma unroll
    for (int qi = 0; qi < 2; ++qi)
#pragma unroll
      for (int d = 0; d < 8; ++d) xb[((rg * 2 + qi) * 8 + d) * 64 + lane] = oacc[qi][d];
  }
  __syncthreads();
  if (c == 0) {
    const float* sw = p.in[5] + j * 128;
    bf16_t* cat = (bf16_t*)(p.ws + OFF_R1);
#pragma unroll
    for (int qi = 0; qi < 2; ++qi) {
      float ss = 0.f;
#pragma unroll
      for (int d = 0; d < 8; ++d) {
        f32x4 o1 = xb[((rg * 2 + qi) * 8 + d) * 64 + lane];
        f32x4 o = oacc[qi][d] - o1 * lam;
        oacc[qi][d] = o;
        ss += o[0] * o[0] + o[1] * o[1] + o[2] * o[2] + o[3] * o[3];
      }
      ss += __shfl_xor(ss, 16);
      ss += __shfl_xor(ss, 32);
      const float r = rsqrtf(ss * (1.f / 128.f) + 1e-6f) * one_m_linit;
      const int qpos = qw + qi * 16 + l15;
      if (qpos < L) {
#pragma unroll
        for (int d = 0; d < 8; ++d) {
          const int dv = d * 16 + quad * 4;
          f32x4 w = *(const f32x4*)(sw + dv);
          f32x4 o = oacc[qi][d] * r * w;
          *(u32x2*)(cat + (size_t)qpos * 1024 + h * 128 + dv) = u32x2{pack2(o[0], o[1]), pack2(o[2], o[3])};
        }
      }
    }
  }
  __syncthreads();
}

DEVI void attn_phase(const Params& p, int j, float lambda_init, char* smem, int* s_item) {
  const int tid = TIDX;
  const float* lv = p.in[4] + j * 256;
  float d01 = 0.f, d23 = 0.f;
  for (int i = 0; i < 64; ++i) {
    d01 += lv[i] * lv[64 + i];
    d23 += lv[128 + i] * lv[192 + i];
  }
  const float lam = expf(d01) - expf(d23) + lambda_init;
  float* tbl = (float*)(smem + 73728);
  int cur_h = -1;
  const int x0 = (int)(xb_xcc_id() & 7u);
  for (int qx = 0; qx < 8; ++qx) {
    const int xq = (x0 + qx) & 7;
    int* counter = (int*)(p.ws + OFF_MISC) + 16 + j * 8 + xq;
    const int h = xq >> 1, par = xq & 1, nq = par ? 128 : 129;
    for (;;) {
      if (tid == 0) *s_item = atomicAdd(counter, 1);
      __syncthreads();
      const int item = *s_item;
      __syncthreads();
      if (item >= nq) break;
      const int qt = (par ? 255 : 256) - 2 * item;
      if (h != cur_h) {
        if (tid < 129) {
          int bucket;
          if (tid < 16) bucket = tid;
          else {
            bucket = 16 + (int)(logf((float)tid / 16.0f) / 2.0794415416798357f * 16.0f);
            bucket = min(bucket, 31);
          }
          tbl[tid] = (p.in[2][bucket * 4 + h] - p.in[2][31 * 4 + h]) * LOG2E;
        }
        cur_h = h;
        __syncthreads();
      }
      attn_item(p, j, h, qt, lam, 1.0f - lambda_init, smem);
    }
  }
  int* pctr = (int*)(p.ws + OFF_MISC) + 8 + j;
  for (;;) {
    if (tid == 0) *s_item = atomicAdd(pctr, 1);
    __syncthreads();
    const int c = *s_item;
    __syncthreads();
    if (c >= POOL_NCHUNK) break;
    pool_chunk(p, c);
  }
}

DEVI void conv_phase(const Params& p, int j) {
  const bf16_t* raw = (const bf16_t*)(p.ws + OFF_R0);
  bf16_t* r1 = (bf16_t*)(p.ws + OFF_R1);
  const float* cw = p.in[10] + (size_t)j * 3072 * 4;
  const int tid = TIDX;
  const int lane = tid & 63;
  const int gw = BIDX * 4 + (tid >> 6), nw = gridDim.x * 4;
  for (int item = gw; item < 1025 * 24; item += nw) {
    const int run = item / 24, seg = item - run * 24;
    const int tb = run * 16;
    const int ch = seg * 128 + lane * 2;
    const f32x4 w0 = *(const f32x4*)(cw + (size_t)ch * 4);
    const f32x4 w1 = *(const f32x4*)(cw + (size_t)ch * 4 + 4);
    unsigned xv[19];
#pragma unroll
    for (int r = 0; r < 19; ++r) {
      const int tt = tb - 3 + r;
      xv[r] = 0;
      if (tt >= 0) xv[r] = *(const unsigned*)(raw + (size_t)tt * 3072 + ch);
    }
    float y0[16], y1[16], ss[16];
#pragma unroll
    for (int i = 0; i < 16; ++i) {
      float a0 = 0.f, a1 = 0.f;
#pragma unroll
      for (int k = 0; k < 4; ++k) {
        a0 += w0[k] * bflo(xv[i + k]);
        a1 += w1[k] * bfhi(xv[i + k]);
      }
      a0 = a0 / (1.f + __expf(-a0));
      a1 = a1 / (1.f + __expf(-a1));
      y0[i] = a0;
      y1[i] = a1;
      ss[i] = a0 * a0 + a1 * a1;
    }
    if (seg < 16) {
#pragma unroll
      for (int m = 32; m >= 1; m >>= 1) {
#pragma unroll
        for (int i = 0; i < 16; ++i) ss[i] += __shfl_xor(ss[i], m);
      }
      const float sc = (seg < 8) ? 0.08838834764831845f : 1.0f;
#pragma unroll
      for (int i = 0; i < 16; ++i) {
        const float r = rsqrtf(ss[i] + 1e-6f) * sc;
        y0[i] *= r;
        y1[i] *= r;
      }
    }
    int chw = ch;
    if (seg < 8) {
      const int cc = lane * 2;
      chw = seg * 128 + (cc & 96) + (((cc >> 2) & 3) << 3) + (((cc >> 4) & 1) << 2) + (cc & 3);
    }
#pragma unroll
    for (int i = 0; i < 16; ++i) *(unsigned*)(r1 + (size_t)(tb + i) * 3072 + chw) = pack2(y0[i], y1[i]);
  }
}

DEVI void prep_item(const Params& p, int j, int n, int h, char* smem) {
  const int tid = TIDX, lane = tid & 63, wave = tid >> 6, l15 = lane & 15, quad = lane >> 4;
  bf16_t* r1 = (bf16_t*)(p.ws + OFF_R1);
  bf16_t* r0 = (bf16_t*)(p.ws + OFF_R0);
  const float* ba = (const float*)(p.ws + OFF_BA);
  char* qs = smem;
  char* ks = smem + 17408;
  char* vs = smem + 34816;
  float* am = (float*)(smem + 52224);
  float* sbeta = (float*)(smem + 69632);
  float* sgc = sbeta + 64;
  const int t0 = n * 64 - 48;
#pragma unroll
  for (int i = 0; i < 4; ++i) {
    const int ch = tid + i * 256, row = ch >> 4, kc = ch & 15;
    const int t = t0 + row;
    u32x4 vq = u32x4{0, 0, 0, 0}, vk = vq, vv = vq;
    if (t >= 0) {
      const bf16_t* src = r1 + (size_t)t * 3072 + h * 128 + kc * 8;
      vq = *(const u32x4*)src;
      vk = *(const u32x4*)(src + 1024);
      vv = *(const u32x4*)(src + 2048);
    }
    {
      const int s_ = kc >> 2, q_ = kc & 3;
      *(u32x2*)(qs + row * 272 + (s_ * 32 + q_ * 4) * 2) = u32x2{vq.x, vq.y};
      *(u32x2*)(qs + row * 272 + (s_ * 32 + 16 + q_ * 4) * 2) = u32x2{vq.z, vq.w};
    }
    *(u32x4*)(ks + row * 272 + kc * 16) = vk;
    *(u32x4*)(vs + row * 272 + kc * 16) = vv;
  }
  if (wave == 0) {
    const int t = t0 + lane;
    float beta = 0.f, g = 0.f;
    if (t >= 0) {
      const float braw = ba[(size_t)t * 16 + h], araw = ba[(size_t)t * 16 + 8 + h];
      beta = 1.f / (1.f + expf(-braw));
      const float x = araw + p.in[12][j * 8 + h];
      const float sp = (x > 20.f) ? x : log1pf(expf(x));
      g = -expf(p.in[11][j * 8 + h]) * sp;
    }
#pragma unroll
    for (int off = 1; off < 64; off <<= 1) {
      const float o = __shfl_up(g, off);
      if (lane >= off) g += o;
    }
    sbeta[lane] = beta;
    sgc[lane] = g;
    {
      const float glast = __shfl(g, 63);
      float* gout = (float*)(r0 + R0_G) + (size_t)(n * 8 + h) * 192;
      gout[lane] = __expf(g);
      gout[64 + lane] = __expf(glast - g);
      if (lane == 0) gout[128] = __expf(glast);
    }
  }
  __syncthreads();
  {
    f32x4 akk[4], aqk[4];
#pragma unroll
    for (int nt = 0; nt < 4; ++nt) akk[nt] = aqk[nt] = f32x4{0.f, 0.f, 0.f, 0.f};
#pragma unroll
    for (int s = 0; s < 4; ++s) {
      bf16x8 ka = *(const bf16x8*)(ks + (wave * 16 + l15) * 272 + s * 64 + quad * 16);
      bf16x8 qa = *(const bf16x8*)(qs + (wave * 16 + l15) * 272 + s * 64 + quad * 16);
#pragma unroll
      for (int nt = 0; nt < 4; ++nt) {
        bf16x8 kb = *(const bf16x8*)(ks + (nt * 16 + l15) * 272 + s * 64 + quad * 16);
        akk[nt] = MFMA16(ka, kb, akk[nt]);
        aqk[nt] = MFMA16(qa, kb, aqk[nt]);
      }
    }
    bf16_t* qkout = r0 + R0_QK + (size_t)(n * 8 + h) * 4096;
#pragma unroll
    for (int nt = 0; nt < 4; ++nt) {
      const int jx = nt * 16 + l15;
      const float gj = sgc[jx];
#pragma unroll
      for (int jj = 0; jj < 4; ++jj) {
        const int i = wave * 16 + quad * 4 + jj;
        const float dec = __expf(fminf(sgc[i] - gj, 0.f));
        am[i * 68 + jx] = (jx < i) ? sbeta[i] * akk[nt][jj] * dec : 0.f;
        qkout[i * 64 + jx] = f2bf((jx <= i) ? aqk[nt][jj] * dec : 0.f);
      }
    }
  }
  __syncthreads();
  {
    bf16_t* kt = r0 + R0_KT + (size_t)(n * 8 + h) * 8192;
#pragma unroll
    for (int i = 0; i < 4; ++i) {
      const int unit = tid + i * 256, d = unit >> 3, i0 = (unit & 7) * 8;
      unsigned e[8];
#pragma unroll
      for (int q = 0; q < 8; ++q) e[q] = *(const unsigned short*)(ks + (i0 + q) * 272 + d * 2);
      u32x4 o = {e[0] | (e[1] << 16), e[2] | (e[3] << 16), e[4] | (e[5] << 16), e[6] | (e[7] << 16)};
      *(u32x4*)(kt + d * 64 + i0) = o;
    }
  }
  {
    const int c = tid;
    const bool isu = c < 128;
    const char* src = isu ? (vs + c * 2) : (ks + (c - 128) * 2);
    float x[64];
#pragma unroll
    for (int i = 0; i < 64; ++i) x[i] = 0.f;
    int zero;
    asm volatile("v_mov_b32 %0, 0" : "=v"(zero));
#pragma unroll
    for (int i = 0; i < 64; ++i) {
      const float* amz = am + zero;
      const float* sbz = sbeta + zero;
      const float eg = __expf(sbz[64 + i]);
      float acc = bf2f(*(const unsigned short*)(src + i * 272)) * sbz[i] * (isu ? 1.0f : eg);
#pragma unroll
      for (int j4 = 0; j4 < (i + 3) / 4; ++j4) {
        const f32x4 a = *(const f32x4*)(amz + i * 68 + j4 * 4);
        acc -= a[0] * x[j4 * 4 + 0];
        acc -= a[1] * x[j4 * 4 + 1];
        acc -= a[2] * x[j4 * 4 + 2];
        acc -= a[3] * x[j4 * 4 + 3];
      }
      asm volatile("" : "+v"(zero), "+v"(acc));
      x[i] = acc;
    }
    bf16_t* dst = r1 + (isu ? 2048 : 1024) + h * 128 + (c & 127);
#pragma unroll
    for (int i = 0; i < 64; ++i) {
      const int t = t0 + i;
      if (t >= 0) dst[(size_t)t * 3072] = f2bf(x[i]);
    }
  }
  __syncthreads();
}

constexpr int NW = 2;
DEVI void scan_item(const Params& p, int h, int sl, char* smem) {
  const int tid = TIDX, lane = tid & 63, wave = tid >> 6, l15 = lane & 15, quad = lane >> 4;
  bf16_t* r1 = (bf16_t*)(p.ws + OFF_R1);
  const bf16_t* r0 = (const bf16_t*)(p.ws + OFF_R0);
  char* wsm = smem;
  char* qksm = smem + 17408;
  char* ktsm = smem + 26624;
  char* usm = smem + 45056;
  float* gsm = (float*)(smem + 50176);
  char* sbx = smem + 51200;
  char* vbx = smem + 59392;
  constexpr int USTR = (NW * 16 + 8) * 2;
  const int vb0 = sl * NW * 16;
  const bool is_state = wave < NW;
  const int cw = is_state ? wave : wave - NW;
  u32x4 pw[4], pqk[2], pkt[4], pg = u32x4{0, 0, 0, 0}, pu = u32x4{0, 0, 0, 0};
  auto gload = [&](int n) {
    const int t0 = n * 64 - 48;
#pragma unroll
    for (int i = 0; i < 4; ++i) {
      const int ch = tid + i * 256, row = ch >> 4, kc = ch & 15;
      const int t = t0 + row;
      pw[i] = u32x4{0, 0, 0, 0};
      if (t >= 0) pw[i] = *(const u32x4*)(r1 + (size_t)t * 3072 + 1024 + h * 128 + kc * 8);
    }
    const bf16_t* qk = r0 + R0_QK + (size_t)(n * 8 + h) * 4096;
#pragma unroll
    for (int i = 0; i < 2; ++i) pqk[i] = *(const u32x4*)(qk + (size_t)(tid + i * 256) * 8);
    const bf16_t* kt = r0 + R0_KT + (size_t)(n * 8 + h) * 8192;
#pragma unroll
    for (int i = 0; i < 4; ++i) pkt[i] = *(const u32x4*)(kt + (size_t)(tid + i * 256) * 8);
    if (tid < 48) pg = *(const u32x4*)((const float*)(r0 + R0_G) + (size_t)(n * 8 + h) * 192 + tid * 4);
    if (tid < 64 * NW * 2) {
      const int row = tid / (NW * 2), kc = tid % (NW * 2);
      const int t = t0 + row;
      pu = u32x4{0, 0, 0, 0};
      if (t >= 0) pu = *(const u32x4*)(r1 + (size_t)t * 3072 + 2048 + h * 128 + vb0 + kc * 8);
    }
  };
  auto lstore = [&]() {
#pragma unroll
    for (int i = 0; i < 4; ++i) {
      const int ch = tid + i * 256, row = ch >> 4, kc = ch & 15;
      *(u32x4*)(wsm + row * 272 + kc * 16) = pw[i];
    }
    if (tid < 48) *(u32x4*)(gsm + tid * 4) = pg;
    if (tid < 64 * NW * 2) {
      const int row = tid / (NW * 2), kc = tid % (NW * 2);
      *(u32x4*)(usm + row * USTR + kc * 16) = pu;
    }
  };
  auto lstore2 = [&]() {
#pragma unroll
    for (int i = 0; i < 2; ++i) {
      const int ch = tid + i * 256, row = ch >> 3, kc = ch & 7;
      *(u32x4*)(qksm + row * 144 + kc * 16) = pqk[i];
    }
#pragma unroll
    for (int i = 0; i < 4; ++i) {
      const int ch = tid + i * 256, row = ch >> 3, kc = ch & 7;
      *(u32x4*)(ktsm + row * 144 + kc * 16) = pkt[i];
    }
  };
  bf16x8 qfr[2][4];
  auto qload = [&](int n) {
    const int t0 = n * 64 - 48;
#pragma unroll
    for (int mt = 0; mt < 2; ++mt) {
      const int t = t0 + (cw * 2 + mt) * 16 + l15;
#pragma unroll
      for (int s = 0; s < 4; ++s) {
        u32x4 v4 = u32x4{0, 0, 0, 0};
        if (t >= 0) v4 = *(const u32x4*)(r1 + (size_t)t * 3072 + h * 128 + s * 32 + quad * 8);
        qfr[mt][s] = __builtin_bit_cast(bf16x8, v4);
      }
    }
  };
  f32x4 S[8];
#pragma unroll
  for (int r = 0; r < 8; ++r) S[r] = f32x4{0.f, 0.f, 0.f, 0.f};
  gload(0);
  if (!is_state) qload(0);
  for (int n = 0; n < NCH; ++n) {
    lstore();
    if (is_state) {
#pragma unroll
      for (int s = 0; s < 4; ++s) *(bf16x8*)(sbx + ((cw * 4 + s) * 64 + lane) * 16) = pack8(S[2 * s], S[2 * s + 1]);
    }
    __syncthreads();
    lstore2();
    if (n + 1 < NCH) gload(n + 1);
    if (is_state) {
      bf16x8 sb[4];
#pragma unroll
      for (int s = 0; s < 4; ++s) sb[s] = pack8(S[2 * s], S[2 * s + 1]);
      f32x4 vnew[4];
#pragma unroll
      for (int mt = 0; mt < 4; ++mt) vnew[mt] = f32x4{0.f, 0.f, 0.f, 0.f};
#pragma unroll
      for (int s = 0; s < 4; ++s) {
#pragma unroll
        for (int mt = 0; mt < 4; ++mt) {
          const char* aw = wsm + (mt * 16 + l15) * 272 + s * 64 + quad * 8;
          bf16x8 wf = mk8(*(const u32x2*)aw, *(const u32x2*)(aw + 32));
          vnew[mt] = MFMA16(wf, sb[s], vnew[mt]);
        }
      }
#pragma unroll
      for (int mt = 0; mt < 4; ++mt) {
#pragma unroll
        for (int jj = 0; jj < 4; ++jj) {
          const int cidx = mt * 16 + quad * 4 + jj;
          const float u = bf2f(*(const unsigned short*)(usm + cidx * USTR + (cw * 16 + l15) * 2));
          vnew[mt][jj] = u - vnew[mt][jj];
        }
      }
#pragma unroll
      for (int s2 = 0; s2 < 2; ++s2)
        *(bf16x8*)(vbx + ((cw * 2 + s2) * 64 + lane) * 16) = pack8(vnew[2 * s2], vnew[2 * s2 + 1]);
      __syncthreads();
      const float eglast = gsm[128];
      bf16x8 vb[2];
#pragma unroll
      for (int mt = 0; mt < 4; ++mt) {
        const f32x4 gd4 = *(const f32x4*)(gsm + 64 + mt * 16 + quad * 4);
        vnew[mt] = vnew[mt] * gd4;
      }
#pragma unroll
      for (int s2 = 0; s2 < 2; ++s2) vb[s2] = pack8(vnew[2 * s2], vnew[2 * s2 + 1]);
#pragma unroll
      for (int r = 0; r < 8; ++r) S[r] = S[r] * eglast;
#pragma unroll
      for (int s2 = 0; s2 < 2; ++s2) {
#pragma unroll
        for (int r = 0; r < 8; ++r) {
          const char* ap = ktsm + (r * 16 + l15) * 144 + s2 * 64 + quad * 8;
          bf16x8 f = mk8(*(const u32x2*)ap, *(const u32x2*)(ap + 32));
          S[r] = MFMA16(f, vb[s2], S[r]);
        }
      }
    } else {
      f32x4 acco[2][NW];
#pragma unroll
      for (int ct = 0; ct < NW; ++ct) {
        bf16x8 sb[4];
#pragma unroll
        for (int s = 0; s < 4; ++s) sb[s] = *(const bf16x8*)(sbx + ((ct * 4 + s) * 64 + lane) * 16);
#pragma unroll
        for (int m = 0; m < 2; ++m) acco[m][ct] = f32x4{0.f, 0.f, 0.f, 0.f};
#pragma unroll
        for (int s = 0; s < 4; ++s)
#pragma unroll
          for (int m = 0; m < 2; ++m) acco[m][ct] = MFMA16(qfr[m][s], sb[s], acco[m][ct]);
      }
      if (n + 1 < NCH) qload(n + 1);
      __syncthreads();
      const int t0 = n * 64 - 48;
#pragma unroll
      for (int m = 0; m < 2; ++m) {
        const int mt = cw * 2 + m;
        bf16x8 qkf[2];
#pragma unroll
        for (int s2 = 0; s2 < 2; ++s2) {
          const char* a = qksm + (mt * 16 + l15) * 144 + s2 * 64 + quad * 8;
          qkf[s2] = mk8(*(const u32x2*)a, *(const u32x2*)(a + 32));
        }
        const f32x4 ge4 = *(const f32x4*)(gsm + mt * 16 + quad * 4);
#pragma unroll
        for (int ct = 0; ct < NW; ++ct) {
          f32x4 a2 = f32x4{0.f, 0.f, 0.f, 0.f};
#pragma unroll
          for (int s2 = 0; s2 < 2; ++s2) {
            const bf16x8 vb = *(const bf16x8*)(vbx + ((ct * 2 + s2) * 64 + lane) * 16);
            a2 = MFMA16(qkf[s2], vb, a2);
          }
#pragma unroll
          for (int jj = 0; jj < 4; ++jj) {
            const int t = t0 + mt * 16 + quad * 4 + jj;
            const float o = ge4[jj] * acco[m][ct][jj] + a2[jj];
            if (t >= 0) r1[(size_t)t * 3072 + 2048 + h * 128 + vb0 + ct * 16 + l15] = f2bf(o);
          }
        }
      }
    }
    __syncthreads();
  }
}

DEVI void gate_phase(const Params& p, int j) {
  bf16_t* r1 = (bf16_t*)(p.ws + OFF_R1);
  const bf16_t* z = (const bf16_t*)(p.ws + OFF_R0) + R0_Z;
  const float* nw = p.in[13] + j * 128;
  const int tid = TIDX;
  const int lane = tid & 63;
  const int gw = BIDX * 4 + (tid >> 6), nwv = gridDim.x * 4;
  const int half = lane >> 5, l31 = lane & 31;
  const f32x4 w = *(const f32x4*)(nw + l31 * 4);
  for (int t = gw; t < L; t += nwv) {
    u32x2 ov[4], zv[4];
#pragma unroll
    for (int q = 0; q < 4; ++q) {
      const int h = q * 2 + half;
      ov[q] = *(const u32x2*)(r1 + (size_t)t * 3072 + 2048 + h * 128 + l31 * 4);
      zv[q] = *(const u32x2*)(z + (size_t)t * 1024 + h * 128 + l31 * 4);
    }
    float ss[4];
#pragma unroll
    for (int q = 0; q < 4; ++q) {
      const float o0 = bflo(ov[q].x), o1 = bfhi(ov[q].x), o2 = bflo(ov[q].y), o3 = bfhi(ov[q].y);
      ss[q] = o0 * o0 + o1 * o1 + o2 * o2 + o3 * o3;
    }
#pragma unroll
    for (int m = 16; m >= 1; m >>= 1) {
#pragma unroll
      for (int q = 0; q < 4; ++q) ss[q] += __shfl_xor(ss[q], m);
    }
#pragma unroll
    for (int q = 0; q < 4; ++q) {
      const int h = q * 2 + half;
      const float r = rsqrtf(ss[q] * (1.f / 128.f) + 1e-6f);
      const float o[4] = {bflo(ov[q].x), bfhi(ov[q].x), bflo(ov[q].y), bfhi(ov[q].y)};
      const float zz[4] = {bflo(zv[q].x), bfhi(zv[q].x), bflo(zv[q].y), bfhi(zv[q].y)};
      float y[4];
#pragma unroll
      for (int e = 0; e < 4; ++e) y[e] = o[e] * r * w[e] * (zz[e] / (1.f + __expf(-zz[e])));
      *(u32x2*)(r1 + (size_t)t * 3072 + h * 128 + l31 * 4) = u32x2{pack2(y[0], y[1]), pack2(y[2], y[3])};
    }
  }
}


#define XB_TMO      128
#define XB_XCNT(j)  (256  + 64 * (j))
#define XB_XSUB(j)  (1280 + 64 * (j))
#define XB_XGEN(j)  (2304 + 64 * (j))
#define XB_TOP      3328
#define XB_TOPGEN   3392
#define XCD_BAR_WORDS 3456
#define XB_SPIN_CAP (1u << 20)
#define LAS __attribute__((address_space(3)))
DEVI unsigned xb_ld(unsigned* p) { return __hip_atomic_load(p, __ATOMIC_RELAXED, __HIP_MEMORY_SCOPE_AGENT); }
DEVI unsigned xb_add(unsigned* p, unsigned v) { return __hip_atomic_fetch_add(p, v, __ATOMIC_RELAXED, __HIP_MEMORY_SCOPE_AGENT); }
#define XB_SPIN(cond, bar) do { unsigned _sp = 0; while (cond) { __builtin_amdgcn_s_sleep(24); \
    if ((++_sp & 255u) == 0u) { if (xb_ld(&(bar)[XB_TMO])) break; if (_sp > XB_SPIN_CAP) { atomicAdd(&(bar)[XB_TMO], 1u); break; } } } } while (0)
struct XcdBarrier {
  unsigned* bar; unsigned x;
  volatile LAS unsigned* st;
};
DEVI XcdBarrier xcd_barrier_post(unsigned* bar, volatile LAS unsigned* st) {
  XcdBarrier b; b.bar = bar; b.x = xb_xcc_id(); b.st = st;
  if (threadIdx.x == 0) (void)xb_add(&bar[XB_XCNT(b.x)], 1u);
  return b;
}
DEVI void xcd_barrier_complete(unsigned* bar, unsigned x, unsigned& nloc, unsigned& nx) {
  const unsigned G = gridDim.x * gridDim.y * gridDim.z;
  unsigned sum, cnt, mine, sp = 0u;
  for (;;) {
    sum = 0u; cnt = 0u; mine = 0u;
#pragma unroll
    for (unsigned j = 0; j < 16; ++j) { const unsigned c = xb_ld(&bar[XB_XCNT(j)]); sum += c; cnt += (c > 0u) ? 1u : 0u; mine = (j == x) ? c : mine; }
    if (sum == G) break;
    __builtin_amdgcn_s_sleep(1);
    if ((++sp & 255u) == 0u) { if (xb_ld(&bar[XB_TMO])) break; if (sp > XB_SPIN_CAP) { atomicAdd(&bar[XB_TMO], 1u); break; } }
  }
  nloc = mine > 0u ? mine : 1u; nx = cnt > 0u ? cnt : 1u;
}
DEVI void xcd_barrier(const XcdBarrier& b) {
  asm volatile("s_waitcnt vmcnt(0)" ::: "memory");
  __syncthreads();
  if (threadIdx.x == 0) {
    unsigned* bar = b.bar;
    __builtin_amdgcn_s_waitcnt(0);
    unsigned nloc = b.st[0], nx = b.st[1];
    if (nloc == 0u) { xcd_barrier_complete(bar, b.x, nloc, nx); b.st[0] = nloc; b.st[1] = nx; }
    const unsigned old = xb_add(&bar[XB_XSUB(b.x)], 1u);
    const unsigned gen = old / nloc;
    if (old + 1u == (gen + 1u) * nloc) {
      __builtin_amdgcn_fence(__ATOMIC_RELEASE, "agent");
      asm volatile("s_waitcnt vmcnt(0)" ::: "memory");
      const unsigned og = xb_add(&bar[XB_TOP], 1u);
      const unsigned tg = og / nx;
      if (og + 1u == (tg + 1u) * nx) xb_add(&bar[XB_TOPGEN], 1u);
      else XB_SPIN(xb_ld(&bar[XB_TOPGEN]) == tg, bar);
      __builtin_amdgcn_fence(__ATOMIC_ACQUIRE, "agent");
      xb_add(&bar[XB_XGEN(b.x)], 1u);
      asm volatile("s_waitcnt vmcnt(0)" ::: "memory");
    } else {
      XB_SPIN(xb_ld(&bar[XB_XGEN(b.x)]) == gen, bar);
      __builtin_amdgcn_fence(__ATOMIC_ACQUIRE, "agent");
      asm volatile("s_waitcnt vmcnt(0)" ::: "memory");
    }
  }
  __syncthreads();
}

#ifndef ENABLE
#define ENABLE 0xFFFF
#endif
#define EN(bit) if constexpr ((ENABLE >> (bit)) & 1)
__global__ void __launch_bounds__(256, 2) mk(Params p_in, int ph_lo, int ph_hi) {
  extern __shared__ __attribute__((aligned(16))) char smem[];
  __shared__ uint4 sh_misc[2];
  int& s_item = *(int*)&sh_misc[1];
  cg::grid_group grid = cg::this_grid();
  if (threadIdx.x == 0) sh_misc[0] = make_uint4(0u, 0u, 0u, 0u);
  __syncthreads();
  const XcdBarrier xb = xcd_barrier_post((unsigned*)(p_in.ws + OFF_BAR), (volatile LAS unsigned*)&sh_misc[0]);
  grid.sync();
  for (int ph = ph_lo; ph < ph_hi; ++ph) {
    long zoff = 0;
    asm volatile("" : "+s"(zoff));
    Params p;
#pragma unroll
    for (int i = 0; i < 21; ++i) p.in[i] = (const float*)((GLOBAL_AS const float*)(p_in.in[i]));
    p.ws = (char*)((GLOBAL_AS char*)(p_in.ws + zoff));
    p.out = (float*)((GLOBAL_AS float*)(p_in.out + zoff));
    bf16_t* hb = (bf16_t*)(p.ws + OFF_HB);
    bf16_t* wb = (bf16_t*)(p.ws + OFF_WB);
    bf16_t* r0 = (bf16_t*)(p.ws + OFF_R0);
    bf16_t* r1 = (bf16_t*)(p.ws + OFF_R1);
    if (ph == 0) {
      EN(0) { init_phase(p); }
      EN(1) { convert_layer(p, 0, smem); }
    } else {
      const int layer = (ph - 1) / 10, sub = (ph - 1) % 10;
      const int j = layer >> 1;
      const bool even = (layer & 1) == 0;
      if (even && sub >= 3 && sub <= 5) continue;
      if (even) {
        if (sub == 0) {
          EN(2) { gemm_phase(hb, 1024, wb + WB_IN, 1024, 16, smem, EpiEvenIn{r0}); }
        } else if (sub == 1) {
          const float linit = 0.8f - 0.6f * expf(-0.3f * (float)layer);
          EN(4) { attn_phase(p, j, linit, smem, &s_item); }
        } else if (sub == 2) {
          EN(2) { gemm_phase(r1, 1024, wb + WB_OUT, 1024, 8, smem, EpiResid{p, layer == 0}); }
        }
      } else {
        if (sub == 0) {
          EN(2) { gemm_phase(hb, 1024, wb + WB_IN, 1024, 25, smem, EpiOddIn{r0, (float*)(p.ws + OFF_BA)}); }
        } else if (sub == 1) {
          EN(5) { conv_phase(p, j); }
        } else if (sub == 2) {
          EN(6) { for (int it = BIDX; it < NCH * 8; it += gridDim.x) prep_item(p, j, it >> 3, it & 7, smem); }
        } else if (sub == 3) {
          const int nitems = 8 * (8 / NW);
          if ((int)BIDX < nitems) {
            EN(7) { scan_item(p, BIDX & 7, BIDX >> 3, smem); }
          } else {
            EN(2) { gemm_phase(hb, 1024, wb + WB_Z, 1024, 8, smem, EpiZ{r0 + R0_Z}, nitems); }
          }
        } else if (sub == 4) {
          EN(8) { gate_phase(p, j); }
        } else if (sub == 5) {
          EN(2) { gemm_phase(r1, 3072, wb + WB_OUT, 1024, 8, smem, EpiResid{p, false}); }
        }
      }
      if (sub == 6) {
        EN(9) { ln_phase(p, p.in[17] + layer * 1024, p.in[18] + layer * 1024); }
      } else if (sub == 7) {
        EN(2) { gemm_phase(hb, 1024, wb + WB_W1, 1024, 32, smem, EpiSqRelu{r0}); }
      } else if (sub == 8) {
        EN(2) { gemm_phase(r0, 4096, wb + WB_W2, 4096, 8, smem, EpiResid{p, false}); }
      } else if (sub == 9) {
        EN(9) { ln_phase(p, p.in[19] + layer * 1024, p.in[20] + layer * 1024, layer < 3); }
        EN(1) { if (layer < 3) convert_layer(p, layer + 1, smem); }
      }
    }
    if (ph + 1 < ph_hi) xcd_barrier(xb);
  }
}

extern "C" void kernel_launch(void* const* d_in, const int* in_sizes, int n_in, void* d_out, int out_size,
                              void* d_ws, size_t ws_size, hipStream_t stream) {
  static int grid_blocks = 0;
  if (!grid_blocks) {
    int dev = 0, cus = 0, per_cu = 0;
    (void)hipGetDevice(&dev);
    (void)hipDeviceGetAttribute(&cus, hipDeviceAttributeMultiprocessorCount, dev);
    (void)hipFuncSetAttribute((const void*)mk, hipFuncAttributeMaxDynamicSharedMemorySize, SMEM_BYTES);
    (void)hipOccupancyMaxActiveBlocksPerMultiprocessor(&per_cu, mk, 256, SMEM_BYTES);
    if (per_cu > 2) per_cu = 2;
    if (per_cu < 1) per_cu = 1;
    grid_blocks = cus * per_cu;
  }
  Params p{};
  for (int i = 0; i < 21; ++i) p.in[i] = (const float*)d_in[i];
  p.out = (float*)d_out;
  p.ws = (char*)d_ws;
  int lo = 0, hi = 41;
  void* args[] = {&p, &lo, &hi};
  (void)hipMemsetAsync((char*)d_ws + OFF_BAR, 0, 16384, stream);
  (void)hipLaunchCooperativeKernel((void*)mk, dim3(grid_blocks), dim3(256), args, SMEM_BYTES, stream);
}
```

```cpp
#include <hip/hip_runtime.h>
#include <hip/hip_cooperative_groups.h>
namespace cg = cooperative_groups;

typedef unsigned short bf16_t;
using bf16x8 = __attribute__((ext_vector_type(8))) short;
using f32x4 = __attribute__((ext_vector_type(4))) float;
using u32x4 = __attribute__((ext_vector_type(4))) unsigned;
using u32x2 = __attribute__((ext_vector_type(2))) unsigned;
typedef __bf16 bf2_t __attribute__((ext_vector_type(2)));
typedef float f2_t __attribute__((ext_vector_type(2)));

#define DEVI __device__ __forceinline__
#define GLOBAL_AS __attribute__((address_space(1)))

DEVI unsigned xb_xcc_id() { return (unsigned)__builtin_amdgcn_s_getreg((3 << 11) | 20) & 0xFu; }
DEVI int opaque_tid() { int t = threadIdx.x; asm volatile("" : "+v"(t)); return t; }
DEVI int opaque_bid() { int b = blockIdx.x; asm volatile("" : "+s"(b)); return b; }
#define TIDX opaque_tid()
#define BIDX opaque_bid()

constexpr int L = 16400;
constexpr int LR = 16512;
constexpr int NMT = 129;
constexpr int NCH = 257;
constexpr float ALPHA = 1.6817928305074290f;
constexpr float LOG2E = 1.4426950408889634f;

constexpr size_t OFF_HB = 0;
constexpr size_t OFF_WB = 33816576;
constexpr size_t OFF_METAH = 61341696;
constexpr size_t OFF_MISC = 61407232;
constexpr size_t OFF_BA = 61411328;
constexpr size_t OFF_R0 = 62468096;
constexpr size_t OFF_R1 = 163917824;
constexpr size_t OFF_BAR = 265367552;
constexpr size_t WB_IN = 0, WB_Z = 3276800, WB_OUT = 4325376, WB_W1 = 5373952, WB_W2 = 9568256;
constexpr size_t R0_Q = 0, R0_K = 8454144, R0_VT = 16908288, R0_U = 25362432;
constexpr size_t R0_KT = 0, R0_QK = 16842752, R0_G = 25264128, R0_Z = 26100000;

constexpr int SMEM_BYTES = 73728 + 1024;

struct Params {
  const float* in[21];
  float* out;
  char* ws;
};

DEVI unsigned pack2(float a, float b) {
  f2_t v = {a, b};
  bf2_t r = __builtin_convertvector(v, bf2_t);
  return __builtin_bit_cast(unsigned, r);
}
DEVI bf16_t f2bf(float a) { return (bf16_t)(pack2(a, 0.f) & 0xffff); }
DEVI float bf2f(bf16_t b) { return __uint_as_float(((unsigned)b) << 16); }
DEVI float bflo(unsigned u) { return __uint_as_float(u << 16); }
DEVI float bfhi(unsigned u) { return __uint_as_float(u & 0xffff0000u); }

DEVI float* hfrow(const Params& p, int t) {
  return t < 16 ? (float*)(p.ws + OFF_METAH) + t * 1024 : p.out + (size_t)(t - 16) * 1024;
}
DEVI float wave_sum(float v) {
#pragma unroll
  for (int m = 32; m >= 1; m >>= 1) v += __shfl_xor(v, m);
  return v;
}
DEVI bf16x8 mk8(u32x2 a, u32x2 b) {
  u32x4 r = {a.x, a.y, b.x, b.y};
  return __builtin_bit_cast(bf16x8, r);
}
DEVI bf16x8 pack8(f32x4 a, f32x4 b) {
  u32x4 r = {pack2(a[0], a[1]), pack2(a[2], a[3]), pack2(b[0], b[1]), pack2(b[2], b[3])};
  return __builtin_bit_cast(bf16x8, r);
}
DEVI size_t wfm(int n, int k, int K) {
  return ((size_t)(n >> 4) * (K >> 5) + (k >> 5)) * 512 + ((((k >> 3) & 3) << 4) + (n & 15)) * 8 + (k & 7);
}
#define MFMA16(a, b, c) __builtin_amdgcn_mfma_f32_16x16x32_bf16((a), (b), (c), 0, 0, 0)

template <class Epi>
DEVI void gemm_tile(const bf16_t* __restrict__ A, int lda, const bf16_t* __restrict__ Bt, int K,
                    int m0, int n0, char* smem, Epi epi) {
  const int tid = TIDX, lane = tid & 63, wave = tid >> 6;
  const int wm = wave >> 1, wn = wave & 1, l15 = lane & 15, quad = lane >> 4;
  f32x4 acc[4][4];
#pragma unroll
  for (int i = 0; i < 4; ++i)
#pragma unroll
    for (int j = 0; j < 4; ++j) acc[i][j] = f32x4{0.f, 0.f, 0.f, 0.f};
  const int lrow = tid >> 3, lkc = tid & 7;
  const bf16_t* ag = A + (size_t)(m0 + lrow) * lda + lkc * 8;
  const bf16_t* bg = Bt + (size_t)(n0 + lrow) * K + lkc * 8;
  u32x4 ra[4], rb[4];
#pragma unroll
  for (int i = 0; i < 4; ++i) {
    ra[i] = *(const u32x4*)(ag + (size_t)(i * 32) * lda);
    rb[i] = *(const u32x4*)(bg + (size_t)(i * 32) * K);
  }
  const int lds_w = lrow * 128 + ((lkc ^ (lrow & 7)) << 4);
#pragma unroll
  for (int i = 0; i < 4; ++i) {
    *(u32x4*)(smem + lds_w + i * 4096) = ra[i];
    *(u32x4*)(smem + 16384 + lds_w + i * 4096) = rb[i];
  }
  __syncthreads();
  const int nk = K >> 6;
  const int sw = (quad ^ (l15 & 7)) << 4;
  const int a_rd = (wm * 64 + l15) * 128 + sw;
  const int b_rd = 16384 + (wn * 64 + l15) * 128 + sw;
  for (int kt = 0; kt < nk; ++kt) {
    const int buf = (kt & 1) * 32768;
    if (kt + 1 < nk) {
#pragma unroll
      for (int i = 0; i < 4; ++i) {
        ra[i] = *(const u32x4*)(ag + (size_t)(i * 32) * lda + (kt + 1) * 64);
        rb[i] = *(const u32x4*)(bg + (size_t)(i * 32) * K + (kt + 1) * 64);
      }
    }
#pragma unroll
    for (int ks = 0; ks < 2; ++ks) {
      bf16x8 af[4], bf[4];
#pragma unroll
      for (int i = 0; i < 4; ++i) {
        af[i] = *(const bf16x8*)(smem + buf + ((a_rd + i * 2048) ^ (ks * 64)));
        bf[i] = *(const bf16x8*)(smem + buf + ((b_rd + i * 2048) ^ (ks * 64)));
      }
#pragma unroll
      for (int mi = 0; mi < 4; ++mi)
#pragma unroll
        for (int ni = 0; ni < 4; ++ni) acc[mi][ni] = MFMA16(bf[ni], af[mi], acc[mi][ni]);
    }
    if (kt + 1 < nk) {
      const int nb = ((kt + 1) & 1) * 32768;
#pragma unroll
      for (int i = 0; i < 4; ++i) {
        *(u32x4*)(smem + nb + lds_w + i * 4096) = ra[i];
        *(u32x4*)(smem + nb + 16384 + lds_w + i * 4096) = rb[i];
      }
    }
    __syncthreads();
  }
#pragma unroll
  for (int mi = 0; mi < 4; ++mi)
#pragma unroll
    for (int ni = 0; ni < 4; ++ni)
      epi(m0 + wm * 64 + mi * 16 + l15, n0 + wn * 64 + ni * 16 + quad * 4, acc[mi][ni]);
}

template <class Epi>
DEVI void gemm_tile256(const bf16_t* __restrict__ A, int lda, const bf16_t* __restrict__ Bt, int K,
                       int m0, int n0, char* smem, Epi epi) {
  const int tid = TIDX, lane = tid & 63, wave = tid >> 6;
  const int wm = wave >> 1, wn = wave & 1, l15 = lane & 15, quad = lane >> 4;
  f32x4 acc[8][4];
#pragma unroll
  for (int i = 0; i < 8; ++i)
#pragma unroll
    for (int j = 0; j < 4; ++j) acc[i][j] = f32x4{0.f, 0.f, 0.f, 0.f};
  const int lrow = tid >> 3, lkc = tid & 7;
  const bf16_t* ag = A + (size_t)(m0 + lrow) * lda + lkc * 8;
  const bf16_t* bg = Bt + (size_t)(n0 + lrow) * K + lkc * 8;
  u32x4 ra[8], rb[4];
  auto gload = [&](int kt) {
#pragma unroll
    for (int i = 0; i < 8; ++i) ra[i] = *(const u32x4*)(ag + (size_t)(i * 32) * lda + kt * 64);
#pragma unroll
    for (int i = 0; i < 4; ++i) rb[i] = *(const u32x4*)(bg + (size_t)(i * 32) * K + kt * 64);
  };
  const int lds_w = lrow * 128 + ((lkc ^ (lrow & 7)) << 4);
  const int nk = K >> 6;
  const int sw = (quad ^ (l15 & 7)) << 4;
  const int a_rd = (wm * 128 + l15) * 128 + sw;
  const int b_rd = 32768 + (wn * 64 + l15) * 128 + sw;
  gload(0);
  for (int kt = 0; kt < nk; ++kt) {
#pragma unroll
    for (int i = 0; i < 8; ++i) *(u32x4*)(smem + lds_w + i * 4096) = ra[i];
#pragma unroll
    for (int i = 0; i < 4; ++i) *(u32x4*)(smem + 32768 + lds_w + i * 4096) = rb[i];
    __syncthreads();
    if (kt + 1 < nk) gload(kt + 1);
#pragma unroll
    for (int ks = 0; ks < 2; ++ks) {
      bf16x8 af[8], bf[4];
#pragma unroll
      for (int i = 0; i < 4; ++i) bf[i] = *(const bf16x8*)(smem + ((b_rd + i * 2048) ^ (ks * 64)));
#pragma unroll
      for (int i = 0; i < 8; ++i) af[i] = *(const bf16x8*)(smem + ((a_rd + i * 2048) ^ (ks * 64)));
#pragma unroll
      for (int mi = 0; mi < 8; ++mi)
#pragma unroll
        for (int ni = 0; ni < 4; ++ni) acc[mi][ni] = MFMA16(bf[ni], af[mi], acc[mi][ni]);
    }
    __syncthreads();
  }
#pragma unroll
  for (int mi = 0; mi < 8; ++mi)
#pragma unroll
    for (int ni = 0; ni < 4; ++ni)
      epi(m0 + wm * 128 + mi * 16 + l15, n0 + wn * 64 + ni * 16 + quad * 4, acc[mi][ni]);
}

template <class Epi>
DEVI void gemm_tile256b(const bf16_t* __restrict__ A, int lda, const bf16_t* __restrict__ Bt, int K,
                        int m0, int n0, char* smem, Epi epi) {
  const int tid = TIDX, lane = tid & 63, wave = tid >> 6;
  const int wm = wave >> 1, wn = wave & 1, l15 = lane & 15, quad = lane >> 4;
  f32x4 acc[8][4];
#pragma unroll
  for (int i = 0; i < 8; ++i)
#pragma unroll
    for (int j = 0; j < 4; ++j) acc[i][j] = f32x4{0.f, 0.f, 0.f, 0.f};
  const int lrow = tid >> 3, lkc = tid & 7;
  const bf16_t* ag = A + (size_t)(m0 + lrow) * lda + lkc * 8;
  const int kb32 = K >> 5;
  const bf16_t* bp = Bt + ((size_t)((n0 + wn * 64) >> 4) * kb32) * 512 + lane * 8;
  u32x4 ra[8];
  bf16x8 b0[4], b1[4];
  const int lds_w = lrow * 128 + ((lkc ^ (lrow & 7)) << 4);
  const int nk = K >> 6;
  const int sw = (quad ^ (l15 & 7)) << 4;
  const int a_rd = (wm * 128 + l15) * 128 + sw;
#pragma unroll
  for (int i = 0; i < 8; ++i) ra[i] = *(const u32x4*)(ag + (size_t)(i * 32) * lda);
#pragma unroll
  for (int i = 0; i < 4; ++i) b0[i] = *(const bf16x8*)(bp + ((size_t)i * kb32) * 512);
#pragma unroll
  for (int i = 0; i < 8; ++i) *(u32x4*)(smem + lds_w + i * 4096) = ra[i];
  __syncthreads();
  for (int kt = 0; kt < nk; ++kt) {
    const char* base = smem + (kt & 1) * 32768;
    const bool more = kt + 1 < nk;
    if (more) {
#pragma unroll
      for (int i = 0; i < 8; ++i) ra[i] = *(const u32x4*)(ag + (size_t)(i * 32) * lda + (kt + 1) * 64);
    }
#pragma unroll
    for (int i = 0; i < 4; ++i) b1[i] = *(const bf16x8*)(bp + ((size_t)i * kb32 + kt * 2 + 1) * 512);
    {
      bf16x8 af[8];
#pragma unroll
      for (int i = 0; i < 8; ++i) af[i] = *(const bf16x8*)(base + a_rd + i * 2048);
#pragma unroll
      for (int mi = 0; mi < 8; ++mi)
#pragma unroll
        for (int ni = 0; ni < 4; ++ni) acc[mi][ni] = MFMA16(b0[ni], af[mi], acc[mi][ni]);
    }
    if (more) {
#pragma unroll
      for (int i = 0; i < 4; ++i) b0[i] = *(const bf16x8*)(bp + ((size_t)i * kb32 + kt * 2 + 2) * 512);
    }
    {
      bf16x8 af[8];
#pragma unroll
      for (int i = 0; i < 8; ++i) af[i] = *(const bf16x8*)(base + ((a_rd + i * 2048) ^ 64));
#pragma unroll
      for (int mi = 0; mi < 8; ++mi)
#pragma unroll
        for (int ni = 0; ni < 4; ++ni) acc[mi][ni] = MFMA16(b1[ni], af[mi], acc[mi][ni]);
    }
    if (more) {
      char* nb = smem + ((kt + 1) & 1) * 32768 + lds_w;
#pragma unroll
      for (int i = 0; i < 8; ++i) *(u32x4*)(nb + i * 4096) = ra[i];
    }
    __syncthreads();
  }
#pragma unroll
  for (int mi = 0; mi < 8; ++mi)
#pragma unroll
    for (int ni = 0; ni < 4; ++ni)
      epi(m0 + wm * 128 + mi * 16 + l15, n0 + wn * 64 + ni * 16 + quad * 4, acc[mi][ni]);
}

template <class Epi>
DEVI void gemm_tail_tile(const bf16_t* __restrict__ A, int lda, const bf16_t* __restrict__ Bt, int K, int n0,
                         char* smem, Epi epi) {
  const int tid = TIDX, lane = tid & 63, wave = tid >> 6, l15 = lane & 15, quad = lane >> 4;
  constexpr int M0 = 16384;
  f32x4 acc[8];
#pragma unroll
  for (int i = 0; i < 8; ++i) acc[i] = f32x4{0.f, 0.f, 0.f, 0.f};
  const int kq = K >> 2;
  const bf16_t* ag = A + (size_t)(M0 + l15) * lda + wave * kq + quad * 8;
  const int kb32 = K >> 5;
  const bf16_t* bg = Bt + ((size_t)(n0 >> 4) * kb32 + ((wave * kq) >> 5)) * 512 + lane * 8;
  bf16x8 a0, a1, b0[8], b1[8];
  auto tload = [&](bf16x8& a, bf16x8 (&b)[8], int k) {
    a = *(const bf16x8*)(ag + k);
#pragma unroll
    for (int nt = 0; nt < 8; ++nt) b[nt] = *(const bf16x8*)(bg + ((size_t)nt * kb32 + (k >> 5)) * 512);
  };
  tload(a0, b0, 0);
  tload(a1, b1, 32);
  for (int k = 0; k < kq; k += 64) {
#pragma unroll
    for (int nt = 0; nt < 8; ++nt) acc[nt] = MFMA16(b0[nt], a0, acc[nt]);
    if (k + 64 < kq) tload(a0, b0, k + 64);
#pragma unroll
    for (int nt = 0; nt < 8; ++nt) acc[nt] = MFMA16(b1[nt], a1, acc[nt]);
    if (k + 96 < kq) tload(a1, b1, k + 96);
  }
  f32x4* red = (f32x4*)smem;
#pragma unroll
  for (int nt = 0; nt < 8; ++nt) red[(wave * 8 + nt) * 64 + lane] = acc[nt];
  __syncthreads();
#pragma unroll
  for (int q = 0; q < 2; ++q) {
    const int nt = wave * 2 + q;
    f32x4 v = red[(0 * 8 + nt) * 64 + lane] + red[(1 * 8 + nt) * 64 + lane] + red[(2 * 8 + nt) * 64 + lane] +
              red[(3 * 8 + nt) * 64 + lane];
    epi(M0 + l15, n0 + nt * 16 + quad * 4, v);
  }
  __syncthreads();
}

template <class Epi>
DEVI void gemm_phase(const bf16_t* A, int lda, const bf16_t* Bt, int K, int nnt, char* smem, Epi epi,
                     int skip = 0) {
  const int nmain = 64 * nnt, ntiles = nmain + nnt;
  const int nb = gridDim.x - skip;
  const int b = BIDX - skip;
  const bool xmap = (skip == 0) && ((nnt & 7) == 0) && ((nb & 63) == 0);
  const int q = xmap ? (b & 7) * (nb >> 3) + (b >> 3) : b;
  for (int t0 = 0; t0 < ntiles; t0 += nb) {
    const int t = t0 + q;
    if (t >= ntiles) break;
    if (t < nmain) {
      int mt, nt;
      if (xmap) {
        const int s_ = t >> 6, w_ = t & 63, spr = nnt >> 3;
        const int sm = s_ / spr, sn = s_ - sm * spr;
        mt = sm * 8 + (w_ >> 3);
        nt = sn * 8 + (w_ & 7);
      } else {
        mt = t / nnt;
        nt = t - mt * nnt;
      }
      gemm_tile256b(A, lda, Bt, K, mt * 256, nt * 128, smem, epi);
    } else {
      gemm_tail_tile(A, lda, Bt, K, (t - nmain) * 128, smem, epi);
    }
  }
}

struct EpiEvenIn {
  bf16_t* r0;
  DEVI void operator()(int m, int n, f32x4 v) const {
    if (n < 1024) {
      if (m >= L) return;
      const bool isq = n < 512;
      const int nn = n & 511;
      const int h = nn >> 7, c = (nn >> 6) & 1, d = nn & 63;
      const float s = isq ? (0.125f * LOG2E) : 1.0f;
      bf16_t* dst = isq ? r0 + R0_Q + ((size_t)(h * 2 + c) * LR + m) * 64 + d
                        : r0 + R0_K + (size_t)(h * 2 + c) * LR * 64 + wfm(m, d, 64);
      *(u32x2*)dst = u32x2{pack2(v[0] * s, v[1] * s), pack2(v[2] * s, v[3] * s)};
    } else if (n < 1536) {
      const int nn = n - 1024;
      bf16_t* dst = r0 + R0_VT + (size_t)nn * LR + m;
      const bool ok = m < L;
#pragma unroll
      for (int i = 0; i < 4; ++i) {
        dst[(size_t)i * LR] = ok ? f2bf(v[i]) : (bf16_t)0;
        if (m >= 16384) {
          dst[(size_t)i * LR + 16] = 0;
          dst[(size_t)i * LR + 32] = 0;
          dst[(size_t)i * LR + 48] = 0;
        }
      }
    } else {
      if (m >= L) return;
      bf16_t* dst = r0 + R0_U + (size_t)m * 512 + (n - 1536);
      *(u32x2*)dst = u32x2{pack2(v[0], v[1]), pack2(v[2], v[3])};
    }
  }
};
struct EpiResid {
  Params p;
  bool first;
  DEVI void operator()(int m, int n, f32x4 v) const {
    if (m >= L) return;
    float* h = hfrow(p, m) + n;
    const float* src = (first && m >= 16) ? p.in[0] + (size_t)(m - 16) * 1024 + n : h;
    f32x4 o = *(const f32x4*)src;
    o = o * ALPHA + v;
    *(f32x4*)h = o;
  }
};
struct EpiOddIn {
  bf16_t* raw;
  float* ba;
  DEVI void operator()(int m, int n, f32x4 v) const {
    if (m >= L) return;
    if (n < 3072) {
      *(u32x2*)(raw + (size_t)m * 3072 + n) = u32x2{pack2(v[0], v[1]), pack2(v[2], v[3])};
    } else if (n < 3088) {
      *(f32x4*)(ba + (size_t)m * 16 + (n - 3072)) = v;
    }
  }
};
struct EpiZ {
  bf16_t* z;
  DEVI void operator()(int m, int n, f32x4 v) const {
    if (m >= L) return;
    *(u32x2*)(z + (size_t)m * 1024 + n) = u32x2{pack2(v[0], v[1]), pack2(v[2], v[3])};
  }
};
struct EpiSqRelu {
  bf16_t* hid;
  DEVI void operator()(int m, int n, f32x4 v) const {
    if (m >= L) return;
    float a = fmaxf(v[0], 0.f), b = fmaxf(v[1], 0.f), c = fmaxf(v[2], 0.f), d = fmaxf(v[3], 0.f);
    *(u32x2*)(hid + (size_t)m * 4096 + n) = u32x2{pack2(a * a, b * b), pack2(c * c, d * d)};
  }
};

DEVI void tconv_seg(const float* src, int ld, int krows, int c0, int ncols, int ndst, bf16_t* dst, int dld,
                    char* smem) {
  float* tile = (float*)smem;
  const int tid = TIDX;
  const int nkt = krows >> 6, nnt = (ndst + 63) >> 6;
  const int lr = tid >> 4, lc = (tid & 15) * 4;
  const int kp = tid & 31, wn = tid >> 5;
  for (int t = BIDX; t < nkt * nnt; t += gridDim.x) {
    const int kt = t % nkt, nt = t / nkt;
    const int k0 = kt * 64, n0 = nt * 64;
#pragma unroll
    for (int i = 0; i < 4; ++i) {
      const int r = i * 16 + lr;
      f32x4 v = f32x4{0.f, 0.f, 0.f, 0.f};
      if (n0 + lc < ncols) v = *(const f32x4*)(src + (size_t)(k0 + r) * ld + c0 + n0 + lc);
      tile[r * 65 + lc + 0] = v[0];
      tile[r * 65 + lc + 1] = v[1];
      tile[r * 65 + lc + 2] = v[2];
      tile[r * 65 + lc + 3] = v[3];
    }
    __syncthreads();
#pragma unroll
    for (int i = 0; i < 8; ++i) {
      const int rn = i * 8 + wn;
      if (n0 + rn < ndst)
        *(unsigned*)(dst + wfm(n0 + rn, k0 + 2 * kp, dld)) = pack2(tile[(2 * kp) * 65 + rn], tile[(2 * kp + 1) * 65 + rn]);
    }
    __syncthreads();
  }
}

DEVI void convert_layer(const Params& p, int layer, char* smem) {
  bf16_t* wb = (bf16_t*)(p.ws + OFF_WB);
  const int j = layer >> 1;
  if ((layer & 1) == 0) {
    tconv_seg(p.in[3] + (size_t)j * 1024 * 2048, 2048, 1024, 0, 2048, 2048, wb + WB_IN, 1024, smem);
    tconv_seg(p.in[8] + (size_t)j * 1024 * 1024, 1024, 512, 0, 1024, 1024, wb + WB_OUT, 1024, smem);
    const float* pw = p.in[6] + (size_t)j * 4 * 128 * 128;
    const float* ps = p.in[7] + (size_t)j * 512;
    const float* wo = p.in[8] + (size_t)j * 1024 * 1024;
    {
      const int tid = TIDX;
      for (int item = BIDX; item < 512; item += gridDim.x) {
        const int g = item >> 7, c = item & 127;
        const float* pwr = pw + ((size_t)g * 128 + c) * 128;
        const float* wor = wo + (size_t)(512 + g * 128) * 1024 + tid * 4;
        f32x4 acc = f32x4{0.f, 0.f, 0.f, 0.f};
#pragma unroll 8
        for (int d = 0; d < 128; ++d) {
          const float a = pwr[d] * ps[g * 128 + d];
          const f32x4 w4 = *(const f32x4*)(wor + (size_t)d * 1024);
          acc = acc + w4 * a;
        }
#pragma unroll
        for (int e = 0; e < 4; ++e) wb[WB_OUT + wfm(tid * 4 + e, 512 + item, 1024)] = f2bf(acc[e]);
      }
    }
  } else {
    const float* wi = p.in[9] + (size_t)j * 1024 * 4112;
    tconv_seg(wi, 4112, 1024, 0, 3072, 3072, wb + WB_IN, 1024, smem);
    tconv_seg(wi, 4112, 1024, 4096, 16, 128, wb + WB_IN + (size_t)3072 * 1024, 1024, smem);
    tconv_seg(wi, 4112, 1024, 3072, 1024, 1024, wb + WB_Z, 1024, smem);
    tconv_seg(p.in[14] + (size_t)j * 1024 * 1024, 1024, 1024, 0, 1024, 1024, wb + WB_OUT, 1024, smem);
  }
  tconv_seg(p.in[15] + (size_t)layer * 1024 * 4096, 4096, 1024, 0, 4096, 4096, wb + WB_W1, 1024, smem);
  tconv_seg(p.in[16] + (size_t)layer * 4096 * 1024, 1024, 4096, 0, 1024, 1024, wb + WB_W2, 4096, smem);
}

DEVI void init_phase(const Params& p) {
  const int gt = BIDX * 256 + TIDX, nth = gridDim.x * 256;
  if (gt < 64) ((int*)(p.ws + OFF_MISC))[gt] = 0;
  bf16_t* hb = (bf16_t*)(p.ws + OFF_HB);
  for (int idx = gt; idx < L * 256; idx += nth) {
    const int t = idx >> 8, c = (idx & 255) * 4;
    f32x4 v = (t < 16) ? *(const f32x4*)(p.in[1] + t * 1024 + c) : *(const f32x4*)(p.in[0] + (size_t)(t - 16) * 1024 + c);
    if (t < 16) *(f32x4*)(hfrow(p, t) + c) = v;
    *(u32x2*)(hb + (size_t)t * 1024 + c) = u32x2{pack2(v[0], v[1]), pack2(v[2], v[3])};
  }
}

DEVI void ln_phase(const Params& p, const float* g, const float* b, bool whb = true) {
  const int tid = TIDX;
  const int lane = tid & 63;
  const int gw = BIDX * 4 + (tid >> 6), nw = gridDim.x * 4;
  bf16_t* hb = (bf16_t*)(p.ws + OFF_HB);
  for (int t0 = gw * 4; t0 < L; t0 += nw * 4) {
    f32x4 v[4][4];
    float* h[4];
#pragma unroll
    for (int r = 0; r < 4; ++r) {
      h[r] = hfrow(p, t0 + r);
#pragma unroll
      for (int i = 0; i < 4; ++i) v[r][i] = *(const f32x4*)(h[r] + i * 256 + lane * 4);
    }
    float s[4], q[4];
#pragma unroll
    for (int r = 0; r < 4; ++r) {
      s[r] = 0.f;
#pragma unroll
      for (int i = 0; i < 4; ++i) s[r] += v[r][i][0] + v[r][i][1] + v[r][i][2] + v[r][i][3];
    }
#pragma unroll
    for (int m = 32; m >= 1; m >>= 1) {
#pragma unroll
      for (int r = 0; r < 4; ++r) s[r] += __shfl_xor(s[r], m);
    }
#pragma unroll
    for (int r = 0; r < 4; ++r) {
      const float mu = s[r] * (1.f / 1024.f);
      q[r] = 0.f;
#pragma unroll
      for (int i = 0; i < 4; ++i) {
        v[r][i] = v[r][i] - mu;
        q[r] += v[r][i][0] * v[r][i][0] + v[r][i][1] * v[r][i][1] + v[r][i][2] * v[r][i][2] + v[r][i][3] * v[r][i][3];
      }
    }
#pragma unroll
    for (int m = 32; m >= 1; m >>= 1) {
#pragma unroll
      for (int r = 0; r < 4; ++r) q[r] += __shfl_xor(q[r], m);
    }
#pragma unroll
    for (int i = 0; i < 4; ++i) {
      const f32x4 gg = *(const f32x4*)(g + i * 256 + lane * 4);
      const f32x4 bb = *(const f32x4*)(b + i * 256 + lane * 4);
#pragma unroll
      for (int r = 0; r < 4; ++r) {
        const float rstd = rsqrtf(q[r] * (1.f / 1024.f) + 1e-5f);
        f32x4 y = v[r][i] * rstd * gg + bb;
        *(f32x4*)(h[r] + i * 256 + lane * 4) = y;
        if (whb) *(u32x2*)(hb + (size_t)(t0 + r) * 1024 + i * 256 + lane * 4) = u32x2{pack2(y[0], y[1]), pack2(y[2], y[3])};
      }
    }
  }
}

constexpr int POOL_CHUNK = 2048, POOL_NCHUNK = (L * 64 + POOL_CHUNK - 1) / POOL_CHUNK;
DEVI void pool_chunk(const Params& p, int chunk) {
  const bf16_t* U = (const bf16_t*)(p.ws + OFF_R0) + R0_U;
  bf16_t* cat = (bf16_t*)(p.ws + OFF_R1);
  const int tid_ = TIDX;
  const int lim = min((chunk + 1) * POOL_CHUNK, L * 64);
  for (int idx = chunk * POOL_CHUNK + tid_; idx < lim; idx += 256) {
    const int t = idx >> 6, cc = idx & 63, g = cc >> 4;
    const int win = 2 << g;
    const int cnt = min(t + 1, win);
    float s[8];
#pragma unroll
    for (int e = 0; e < 8; ++e) s[e] = 0.f;
    u32x4 self = u32x4{0, 0, 0, 0};
    u32x4 tv[16];
#pragma unroll
    for (int k = 0; k < 16; ++k) {
      tv[k] = u32x4{0, 0, 0, 0};
      if (k < cnt) tv[k] = *(const u32x4*)(U + (size_t)(t - k) * 512 + cc * 8);
    }
    self = tv[0];
#pragma unroll
    for (int k = 0; k < 16; ++k) {
#pragma unroll
      for (int e = 0; e < 4; ++e) {
        s[2 * e] += bflo(tv[k][e]);
        s[2 * e + 1] += bfhi(tv[k][e]);
      }
    }
    const float inv = 1.f / (float)cnt;
    u32x4 o;
#pragma unroll
    for (int e = 0; e < 4; ++e) o[e] = pack2(s[2 * e] * inv - bflo(self[e]), s[2 * e + 1] * inv - bfhi(self[e]));
    *(u32x4*)(cat + (size_t)t * 1024 + 512 + cc * 8) = o;
  }
}

DEVI void attn_item(const Params& p, int j, int h, int qt, float lam, float one_m_linit, char* smem) {
  const int tid = TIDX, lane = tid & 63, wave = tid >> 6;
  const int rg = wave & 1, c = wave >> 1, l15 = lane & 15, quad = lane >> 4;
  const bf16_t* r0 = (const bf16_t*)(p.ws + OFF_R0);
  const bf16_t* Qg = r0 + R0_Q + (size_t)(h * 2 + c) * LR * 64;
  const bf16_t* Kfm = r0 + R0_K + (size_t)(h * 2 + c) * LR * 64 + lane * 8;
  const bf16_t* Vg = r0 + R0_VT + (size_t)(h * 128) * LR;
  const float* tbl = (const float*)(smem + 73728);
  const int q0 = qt * 64;
  const int qw = q0 + rg * 32;
  bf16x8 qf[2][2];
#pragma unroll
  for (int qi = 0; qi < 2; ++qi)
#pragma unroll
    for (int ks = 0; ks < 2; ++ks)
      qf[qi][ks] = *(const bf16x8*)(Qg + (size_t)(qw + qi * 16 + l15) * 64 + ks * 32 + quad * 8);
  f32x4 oacc[2][8];
#pragma unroll
  for (int qi = 0; qi < 2; ++qi)
#pragma unroll
    for (int d = 0; d < 8; ++d) oacc[qi][d] = f32x4{0.f, 0.f, 0.f, 0.f};
  float mrun[2] = {0.f, 0.f};
  f32x4 lacc[2] = {f32x4{0.f, 0.f, 0.f, 0.f}, f32x4{0.f, 0.f, 0.f, 0.f}};
  const bf16x8 ones = {16256, 16256, 16256, 16256, 16256, 16256, 16256, 16256};
  const int nkt = qt + 1;
  const int krow = tid >> 3, kkc = tid & 7;
  u32x4 rv[4];
  auto gload = [&](int kt) {
    const int k0 = kt * 64;
#pragma unroll
    for (int i = 0; i < 4; ++i) rv[i] = *(const u32x4*)(Vg + (size_t)(krow + i * 32) * LR + k0 + kkc * 8);
  };
  auto lstore = [&](int buf) {
    char* b = smem + buf * 34816;
#pragma unroll
    for (int i = 0; i < 4; ++i) *(u32x4*)(b + 16384 + (krow + i * 32) * 144 + kkc * 16) = rv[i];
  };
  bf16x8 kf[4][2];
  auto kload = [&](int kt) {
#pragma unroll
    for (int ki = 0; ki < 4; ++ki)
#pragma unroll
      for (int ks = 0; ks < 2; ++ks) kf[ki][ks] = *(const bf16x8*)(Kfm + ((size_t)((kt * 4 + ki) * 2 + ks)) * 512);
  };
  gload(0);
  kload(0);
  lstore(0);
  __syncthreads();
  for (int kt = 0; kt < nkt; ++kt) {
    const char* b = smem + (kt & 1) * 34816;
    if (kt + 1 < nkt) gload(kt + 1);
    const int k0 = kt * 64;
    if (k0 <= qw + 31) {
      f32x4 st[2][4];
#pragma unroll
      for (int qi = 0; qi < 2; ++qi)
#pragma unroll
        for (int ki = 0; ki < 4; ++ki) st[qi][ki] = f32x4{-mrun[qi], -mrun[qi], -mrun[qi], -mrun[qi]};
      const char* vb = b + 16384;
      bf16x8 vf[2][4];
      auto vload = [&](int g, int slot) {
#pragma unroll
        for (int dd = 0; dd < 2; ++dd)
#pragma unroll
          for (int s2 = 0; s2 < 2; ++s2) {
            const char* a = vb + ((g * 2 + dd) * 16 + l15) * 144 + s2 * 64 + quad * 8;
            vf[slot][dd * 2 + s2] = mk8(*(const u32x2*)a, *(const u32x2*)(a + 32));
          }
      };
      __builtin_amdgcn_s_setprio(2);
#pragma unroll
      for (int ki = 0; ki < 4; ++ki)
#pragma unroll
        for (int ks = 0; ks < 2; ++ks) {
#pragma unroll
          for (int qi = 0; qi < 2; ++qi) st[qi][ki] = MFMA16(kf[ki][ks], qf[qi][ks], st[qi][ki]);
        }
      __builtin_amdgcn_s_setprio(0);
      if (kt + 1 < nkt) kload(kt + 1);
      __builtin_amdgcn_sched_barrier(0);
      const bool far = (qw - (k0 + 63)) >= 128;
      const bool first = (kt == 0);
#pragma unroll
      for (int qi = 0; qi < 2; ++qi) {
        if (!far) {
          const int qpos = qw + qi * 16 + l15;
#pragma unroll
          for (int ki = 0; ki < 4; ++ki)
#pragma unroll
            for (int jj = 0; jj < 4; ++jj) {
              const int n = qpos - (k0 + ki * 16 + quad * 4 + jj);
              st[qi][ki][jj] = (n >= 0) ? st[qi][ki][jj] + tbl[min(n, 128)] : -1e30f;
            }
        }
        float tmax = st[qi][0][0];
#pragma unroll
        for (int ki = 0; ki < 4; ++ki)
#pragma unroll
          for (int jj = 0; jj < 4; jj += 2) tmax = fmaxf(fmaxf(tmax, st[qi][ki][jj]), st[qi][ki][jj + 1]);
        tmax = fmaxf(tmax, __shfl_xor(tmax, 16));
        tmax = fmaxf(tmax, __shfl_xor(tmax, 32));
        if (first || __any(tmax > 8.0f)) {
          const float dm = first ? tmax : fmaxf(tmax, 0.f);
          const float alpha = __builtin_amdgcn_exp2f(-dm);
          mrun[qi] += dm;
          lacc[qi] = lacc[qi] * alpha;
#pragma unroll
          for (int d = 0; d < 8; ++d) oacc[qi][d] = oacc[qi][d] * alpha;
#pragma unroll
          for (int ki = 0; ki < 4; ++ki) st[qi][ki] = st[qi][ki] - dm;
        }
#pragma unroll
        for (int ki = 0; ki < 4; ++ki)
#pragma unroll
          for (int jj = 0; jj < 4; ++jj) st[qi][ki][jj] = __builtin_amdgcn_exp2f(st[qi][ki][jj]);
      }
      vload(0, 0);
      bf16x8 pb[2][2];
#pragma unroll
      for (int qi = 0; qi < 2; ++qi)
#pragma unroll
        for (int s2 = 0; s2 < 2; ++s2) pb[qi][s2] = pack8(st[qi][2 * s2], st[qi][2 * s2 + 1]);
      __builtin_amdgcn_s_setprio(2);
#pragma unroll
      for (int qi = 0; qi < 2; ++qi)
#pragma unroll
        for (int s2 = 0; s2 < 2; ++s2) lacc[qi] = MFMA16(ones, pb[qi][s2], lacc[qi]);
#pragma unroll
      for (int g = 0; g < 4; ++g) {
        if (g < 3) vload(g + 1, (g + 1) & 1);
#pragma unroll
        for (int dd = 0; dd < 2; ++dd)
#pragma unroll
          for (int s2 = 0; s2 < 2; ++s2)
#pragma unroll
            for (int qi = 0; qi < 2; ++qi)
              oacc[qi][g * 2 + dd] = MFMA16(vf[g & 1][dd * 2 + s2], pb[qi][s2], oacc[qi][g * 2 + dd]);
        __builtin_amdgcn_sched_barrier(0);
      }
      __builtin_amdgcn_s_setprio(0);
    }
    if (kt + 1 < nkt) lstore((kt + 1) & 1);
    __syncthreads();
  }
#pragma unroll
  for (int qi = 0; qi < 2; ++qi) {
    const float inv = 1.f / lacc[qi][0];
#pragma unroll
    for (int d = 0; d < 8; ++d) oacc[qi][d] = oacc[qi][d] * inv;
  }
  f32x4* xb = (f32x4*)smem;
  if (c == 1) {
#pragma unroll
    for (int qi = 0; qi < 2; ++qi)
#pragma unroll
      for (int d = 0; d < 8; ++d) xb[((rg * 2 + qi) * 8 + d) * 64 + lane] = oacc[qi][d];
  }
  __syncthreads();
  if (c == 0) {
    const float* sw = p.in[5] + j * 128;
    bf16_t* cat = (bf16_t*)(p.ws + OFF_R1);
#pragma unroll
    for (int qi = 0; qi < 2; ++qi) {
      float ss = 0.f;
#pragma unroll
      for (int d = 0; d < 8; ++d) {
        f32x4 o1 = xb[((rg * 2 + qi) * 8 + d) * 64 + lane];
        f32x4 o = oacc[qi][d] - o1 * lam;
        oacc[qi][d] = o;
        ss += o[0] * o[0] + o[1] * o[1] + o[2] * o[2] + o[3] * o[3];
      }
      ss += __shfl_xor(ss, 16);
      ss += __shfl_xor(ss, 32);
      const float r = rsqrtf(ss * (1.f / 128.f) + 1e-6f) * one_m_linit;
      const int qpos = qw + qi * 16 + l15;
      if (qpos < L) {
#pragma unroll
        for (int d = 0; d < 8; ++d) {
          const int dv = d * 16 + quad * 4;
          f32x4 w = *(const f32x4*)(sw + dv);
          f32x4 o = oacc[qi][d] * r * w;
          *(u32x2*)(cat + (size_t)qpos * 1024 + h * 128 + dv) = u32x2{pack2(o[0], o[1]), pack2(o[2], o[3])};
        }
      }
    }
  }
  __syncthreads();
}

DEVI void attn_phase(const Params& p, int j, float lambda_init, char* smem, int* s_item) {
  const int tid = TIDX;
  const float* lv = p.in[4] + j * 256;
  float d01 = 0.f, d23 = 0.f;
  for (int i = 0; i < 64; ++i) {
    d01 += lv[i] * lv[64 + i];
    d23 += lv[128 + i] * lv[192 + i];
  }
  const float lam = expf(d01) - expf(d23) + lambda_init;
  float* tbl = (float*)(smem + 73728);
  int cur_h = -1;
  const int x0 = (int)(xb_xcc_id() & 7u);
  for (int qx = 0; qx < 8; ++qx) {
    const int xq = (x0 + qx) & 7;
    int* counter = (int*)(p.ws + OFF_MISC) + 16 + j * 8 + xq;
    const int h = xq >> 1, par = xq & 1, nq = par ? 128 : 129;
    for (;;) {
      if (tid == 0) *s_item = atomicAdd(counter, 1);
      __syncthreads();
      const int item = *s_item;
      __syncthreads();
      if (item >= nq) break;
      const int qt = (par ? 255 : 256) - 2 * item;
      if (h != cur_h) {
        if (tid < 129) {
          int bucket;
          if (tid < 16) bucket = tid;
          else {
            bucket = 16 + (int)(logf((float)tid / 16.0f) / 2.0794415416798357f * 16.0f);
            bucket = min(bucket, 31);
          }
          tbl[tid] = (p.in[2][bucket * 4 + h] - p.in[2][31 * 4 + h]) * LOG2E;
        }
        cur_h = h;
        __syncthreads();
      }
      attn_item(p, j, h, qt, lam, 1.0f - lambda_init, smem);
    }
  }
  int* pctr = (int*)(p.ws + OFF_MISC) + 8 + j;
  for (;;) {
    if (tid == 0) *s_item = atomicAdd(pctr, 1);
    __syncthreads();
    const int c = *s_item;
    __syncthreads();
    if (c >= POOL_NCHUNK) break;
    pool_chunk(p, c);
  }
}

DEVI void conv_phase(const Params& p, int j) {
  const bf16_t* raw = (const bf16_t*)(p.ws + OFF_R0);
  bf16_t* r1 = (bf16_t*)(p.ws + OFF_R1);
  const float* cw = p.in[10] + (size_t)j * 3072 * 4;
  const int tid = TIDX;
  const int lane = tid & 63;
  const int gw = BIDX * 4 + (tid >> 6), nw = gridDim.x * 4;
  for (int item = gw; item < 1025 * 24; item += nw) {
    const int run = item / 24, seg = item - run * 24;
    const int tb = run * 16;
    const int ch = seg * 128 + lane * 2;
    const f32x4 w0 = *(const f32x4*)(cw + (size_t)ch * 4);
    const f32x4 w1 = *(const f32x4*)(cw + (size_t)ch * 4 + 4);
    unsigned xv[19];
#pragma unroll
    for (int r = 0; r < 19; ++r) {
      const int tt = tb - 3 + r;
      xv[r] = 0;
      if (tt >= 0) xv[r] = *(const unsigned*)(raw + (size_t)tt * 3072 + ch);
    }
    float y0[16], y1[16], ss[16];
#pragma unroll
    for (int i = 0; i < 16; ++i) {
      float a0 = 0.f, a1 = 0.f;
#pragma unroll
      for (int k = 0; k < 4; ++k) {
        a0 += w0[k] * bflo(xv[i + k]);
        a1 += w1[k] * bfhi(xv[i + k]);
      }
      a0 = a0 / (1.f + __expf(-a0));
      a1 = a1 / (1.f + __expf(-a1));
      y0[i] = a0;
      y1[i] = a1;
      ss[i] = a0 * a0 + a1 * a1;
    }
    if (seg < 16) {
#pragma unroll
      for (int m = 32; m >= 1; m >>= 1) {
#pragma unroll
        for (int i = 0; i < 16; ++i) ss[i] += __shfl_xor(ss[i], m);
      }
      const float sc = (seg < 8) ? 0.08838834764831845f : 1.0f;
#pragma unroll
      for (int i = 0; i < 16; ++i) {
        const float r = rsqrtf(ss[i] + 1e-6f) * sc;
        y0[i] *= r;
        y1[i] *= r;
      }
    }
    int chw = ch;
    if (seg < 8) {
      const int cc = lane * 2;
      chw = seg * 128 + (cc & 96) + (((cc >> 2) & 3) << 3) + (((cc >> 4) & 1) << 2) + (cc & 3);
    }
#pragma unroll
    for (int i = 0; i < 16; ++i) *(unsigned*)(r1 + (size_t)(tb + i) * 3072 + chw) = pack2(y0[i], y1[i]);
  }
}

DEVI void prep_item(const Params& p, int j, int n, int h, char* smem) {
  const int tid = TIDX, lane = tid & 63, wave = tid >> 6, l15 = lane & 15, quad = lane >> 4;
  bf16_t* r1 = (bf16_t*)(p.ws + OFF_R1);
  bf16_t* r0 = (bf16_t*)(p.ws + OFF_R0);
  const float* ba = (const float*)(p.ws + OFF_BA);
  char* qs = smem;
  char* ks = smem + 17408;
  char* vs = smem + 34816;
  float* am = (float*)(smem + 52224);
  float* sbeta = (float*)(smem + 69632);
  float* sgc = sbeta + 64;
  const int t0 = n * 64 - 48;
#pragma unroll
  for (int i = 0; i < 4; ++i) {
    const int ch = tid + i * 256, row = ch >> 4, kc = ch & 15;
    const int t = t0 + row;
    u32x4 vq = u32x4{0, 0, 0, 0}, vk = vq, vv = vq;
    if (t >= 0) {
      const bf16_t* src = r1 + (size_t)t * 3072 + h * 128 + kc * 8;
      vq = *(const u32x4*)src;
      vk = *(const u32x4*)(src + 1024);
      vv = *(const u32x4*)(src + 2048);
    }
    {
      const int s_ = kc >> 2, q_ = kc & 3;
      *(u32x2*)(qs + row * 272 + (s_ * 32 + q_ * 4) * 2) = u32x2{vq.x, vq.y};
      *(u32x2*)(qs + row * 272 + (s_ * 32 + 16 + q_ * 4) * 2) = u32x2{vq.z, vq.w};
    }
    *(u32x4*)(ks + row * 272 + kc * 16) = vk;
    *(u32x4*)(vs + row * 272 + kc * 16) = vv;
  }
  if (wave == 0) {
    const int t = t0 + lane;
    float beta = 0.f, g = 0.f;
    if (t >= 0) {
      const float braw = ba[(size_t)t * 16 + h], araw = ba[(size_t)t * 16 + 8 + h];
      beta = 1.f / (1.f + expf(-braw));
      const float x = araw + p.in[12][j * 8 + h];
      const float sp = (x > 20.f) ? x : log1pf(expf(x));
      g = -expf(p.in[11][j * 8 + h]) * sp;
    }
#pragma unroll
    for (int off = 1; off < 64; off <<= 1) {
      const float o = __shfl_up(g, off);
      if (lane >= off) g += o;
    }
    sbeta[lane] = beta;
    sgc[lane] = g;
    {
      const float glast = __shfl(g, 63);
      float* gout = (float*)(r0 + R0_G) + (size_t)(n * 8 + h) * 192;
      gout[lane] = __expf(g);
      gout[64 + lane] = __expf(glast - g);
      if (lane == 0) gout[128] = __expf(glast);
    }
  }
  __syncthreads();
  {
    f32x4 akk[4], aqk[4];
#pragma unroll
    for (int nt = 0; nt < 4; ++nt) akk[nt] = aqk[nt] = f32x4{0.f, 0.f, 0.f, 0.f};
#pragma unroll
    for (int s = 0; s < 4; ++s) {
      bf16x8 ka = *(const bf16x8*)(ks + (wave * 16 + l15) * 272 + s * 64 + quad * 16);
      bf16x8 qa = *(const bf16x8*)(qs + (wave * 16 + l15) * 272 + s * 64 + quad * 16);
#pragma unroll
      for (int nt = 0; nt < 4; ++nt) {
        bf16x8 kb = *(const bf16x8*)(ks + (nt * 16 + l15) * 272 + s * 64 + quad * 16);
        akk[nt] = MFMA16(ka, kb, akk[nt]);
        aqk[nt] = MFMA16(qa, kb, aqk[nt]);
      }
    }
    bf16_t* qkout = r0 + R0_QK + (size_t)(n * 8 + h) * 4096;
#pragma unroll
    for (int nt = 0; nt < 4; ++nt) {
      const int jx = nt * 16 + l15;
      const float gj = sgc[jx];
#pragma unroll
      for (int jj = 0; jj < 4; ++jj) {
        const int i = wave * 16 + quad * 4 + jj;
        const float dec = __expf(fminf(sgc[i] - gj, 0.f));
        am[i * 68 + jx] = (jx < i) ? sbeta[i] * akk[nt][jj] * dec : 0.f;
        qkout[i * 64 + jx] = f2bf((jx <= i) ? aqk[nt][jj] * dec : 0.f);
      }
    }
  }
  __syncthreads();
  {
    bf16_t* kt = r0 + R0_KT + (size_t)(n * 8 + h) * 8192;
#pragma unroll
    for (int i = 0; i < 4; ++i) {
      const int unit = tid + i * 256, d = unit >> 3, i0 = (unit & 7) * 8;
      unsigned e[8];
#pragma unroll
      for (int q = 0; q < 8; ++q) e[q] = *(const unsigned short*)(ks + (i0 + q) * 272 + d * 2);
      u32x4 o = {e[0] | (e[1] << 16), e[2] | (e[3] << 16), e[4] | (e[5] << 16), e[6] | (e[7] << 16)};
      *(u32x4*)(kt + d * 64 + i0) = o;
    }
  }
  {
    const int c = tid;
    const bool isu = c < 128;
    const char* src = isu ? (vs + c * 2) : (ks + (c - 128) * 2);
    float x[64];
#pragma unroll
    for (int i = 0; i < 64; ++i) x[i] = 0.f;
    int zero;
    asm volatile("v_mov_b32 %0, 0" : "=v"(zero));
#pragma unroll
    for (int i = 0; i < 64; ++i) {
      const float* amz = am + zero;
      const float* sbz = sbeta + zero;
      const float eg = __expf(sbz[64 + i]);
      float acc = bf2f(*(const unsigned short*)(src + i * 272)) * sbz[i] * (isu ? 1.0f : eg);
#pragma unroll
      for (int j4 = 0; j4 < (i + 3) / 4; ++j4) {
        const f32x4 a = *(const f32x4*)(amz + i * 68 + j4 * 4);
        acc -= a[0] * x[j4 * 4 + 0];
        acc -= a[1] * x[j4 * 4 + 1];
        acc -= a[2] * x[j4 * 4 + 2];
        acc -= a[3] * x[j4 * 4 + 3];
      }
      asm volatile("" : "+v"(zero), "+v"(acc));
      x[i] = acc;
    }
    bf16_t* dst = r1 + (isu ? 2048 : 1024) + h * 128 + (c & 127);
#pragma unroll
    for (int i = 0; i < 64; ++i) {
      const int t = t0 + i;
      if (t >= 0) dst[(size_t)t * 3072] = f2bf(x[i]);
    }
  }
  __syncthreads();
}

constexpr int NW = 2;
DEVI void scan_item(const Params& p, int h, int sl, char* smem) {
  const int tid = TIDX, lane = tid & 63, wave = tid >> 6, l15 = lane & 15, quad = lane >> 4;
  bf16_t* r1 = (bf16_t*)(p.ws + OFF_R1);
  const bf16_t* r0 = (const bf16_t*)(p.ws + OFF_R0);
  char* wsm = smem;
  char* qksm = smem + 17408;
  char* ktsm = smem + 26624;
  char* usm = smem + 45056;
  float* gsm = (float*)(smem + 50176);
  char* sbx = smem + 51200;
  char* vbx = smem + 59392;
  constexpr int USTR = (NW * 16 + 8) * 2;
  const int vb0 = sl * NW * 16;
  const bool is_state = wave < NW;
  const int cw = is_state ? wave : wave - NW;
  u32x4 pw[4], pqk[2], pkt[4], pg = u32x4{0, 0, 0, 0}, pu = u32x4{0, 0, 0, 0};
  auto gload = [&](int n) {
    const int t0 = n * 64 - 48;
#pragma unroll
    for (int i = 0; i < 4; ++i) {
      const int ch = tid + i * 256, row = ch >> 4, kc = ch & 15;
      const int t = t0 + row;
      pw[i] = u32x4{0, 0, 0, 0};
      if (t >= 0) pw[i] = *(const u32x4*)(r1 + (size_t)t * 3072 + 1024 + h * 128 + kc * 8);
    }
    const bf16_t* qk = r0 + R0_QK + (size_t)(n * 8 + h) * 4096;
#pragma unroll
    for (int i = 0; i < 2; ++i) pqk[i] = *(const u32x4*)(qk + (size_t)(tid + i * 256) * 8);
    const bf16_t* kt = r0 + R0_KT + (size_t)(n * 8 + h) * 8192;
#pragma unroll
    for (int i = 0; i < 4; ++i) pkt[i] = *(const u32x4*)(kt + (size_t)(tid + i * 256) * 8);
    if (tid < 48) pg = *(const u32x4*)((const float*)(r0 + R0_G) + (size_t)(n * 8 + h) * 192 + tid * 4);
    if (tid < 64 * NW * 2) {
      const int row = tid / (NW * 2), kc = tid % (NW * 2);
      const int t = t0 + row;
      pu = u32x4{0, 0, 0, 0};
      if (t >= 0) pu = *(const u32x4*)(r1 + (size_t)t * 3072 + 2048 + h * 128 + vb0 + kc * 8);
    }
  };
  auto lstore = [&]() {
#pragma unroll
    for (int i = 0; i < 4; ++i) {
      const int ch = tid + i * 256, row = ch >> 4, kc = ch & 15;
      *(u32x4*)(wsm + row * 272 + kc * 16) = pw[i];
    }
    if (tid < 48) *(u32x4*)(gsm + tid * 4) = pg;
    if (tid < 64 * NW * 2) {
      const int row = tid / (NW * 2), kc = tid % (NW * 2);
      *(u32x4*)(usm + row * USTR + kc * 16) = pu;
    }
  };
  auto lstore2 = [&]() {
#pragma unroll
    for (int i = 0; i < 2; ++i) {
      const int ch = tid + i * 256, row = ch >> 3, kc = ch & 7;
      *(u32x4*)(qksm + row * 144 + kc * 16) = pqk[i];
    }
#pragma unroll
    for (int i = 0; i < 4; ++i) {
      const int ch = tid + i * 256, row = ch >> 3, kc = ch & 7;
      *(u32x4*)(ktsm + row * 144 + kc * 16) = pkt[i];
    }
  };
  bf16x8 qfr[2][4];
  auto qload = [&](int n) {
    const int t0 = n * 64 - 48;
#pragma unroll
    for (int mt = 0; mt < 2; ++mt) {
      const int t = t0 + (cw * 2 + mt) * 16 + l15;
#pragma unroll
      for (int s = 0; s < 4; ++s) {
        u32x4 v4 = u32x4{0, 0, 0, 0};
        if (t >= 0) v4 = *(const u32x4*)(r1 + (size_t)t * 3072 + h * 128 + s * 32 + quad * 8);
        qfr[mt][s] = __builtin_bit_cast(bf16x8, v4);
      }
    }
  };
  f32x4 S[8];
#pragma unroll
  for (int r = 0; r < 8; ++r) S[r] = f32x4{0.f, 0.f, 0.f, 0.f};
  gload(0);
  if (!is_state) qload(0);
  for (int n = 0; n < NCH; ++n) {
    lstore();
    if (is_state) {
#pragma unroll
      for (int s = 0; s < 4; ++s) *(bf16x8*)(sbx + ((cw * 4 + s) * 64 + lane) * 16) = pack8(S[2 * s], S[2 * s + 1]);
    }
    __syncthreads();
    lstore2();
    if (n + 1 < NCH) gload(n + 1);
    if (is_state) {
      bf16x8 sb[4];
#pragma unroll
      for (int s = 0; s < 4; ++s) sb[s] = pack8(S[2 * s], S[2 * s + 1]);
      f32x4 vnew[4];
#pragma unroll
      for (int mt = 0; mt < 4; ++mt) vnew[mt] = f32x4{0.f, 0.f, 0.f, 0.f};
#pragma unroll
      for (int s = 0; s < 4; ++s) {
#pragma unroll
        for (int mt = 0; mt < 4; ++mt) {
          const char* aw = wsm + (mt * 16 + l15) * 272 + s * 64 + quad * 8;
          bf16x8 wf = mk8(*(const u32x2*)aw, *(const u32x2*)(aw + 32));
          vnew[mt] = MFMA16(wf, sb[s], vnew[mt]);
        }
      }
#pragma unroll
      for (int mt = 0; mt < 4; ++mt) {
#pragma unroll
        for (int jj = 0; jj < 4; ++jj) {
          const int cidx = mt * 16 + quad * 4 + jj;
          const float u = bf2f(*(const unsigned short*)(usm + cidx * USTR + (cw * 16 + l15) * 2));
          vnew[mt][jj] = u - vnew[mt][jj];
        }
      }
#pragma unroll
      for (int s2 = 0; s2 < 2; ++s2)
        *(bf16x8*)(vbx + ((cw * 2 + s2) * 64 + lane) * 16) = pack8(vnew[2 * s2], vnew[2 * s2 + 1]);
      __syncthreads();
      const float eglast = gsm[128];
      bf16x8 vb[2];
#pragma unroll
      for (int mt = 0; mt < 4; ++mt) {
        const f32x4 gd4 = *(const f32x4*)(gsm + 64 + mt * 16 + quad * 4);
        vnew[mt] = vnew[mt] * gd4;
      }
#pragma unroll
      for (int s2 = 0; s2 < 2; ++s2) vb[s2] = pack8(vnew[2 * s2], vnew[2 * s2 + 1]);
#pragma unroll
      for (int r = 0; r < 8; ++r) S[r] = S[r] * eglast;
#pragma unroll
      for (int s2 = 0; s2 < 2; ++s2) {
#pragma unroll
        for (int r = 0; r < 8; ++r) {
          const char* ap = ktsm + (r * 16 + l15) * 144 + s2 * 64 + quad * 8;
          bf16x8 f = mk8(*(const u32x2*)ap, *(const u32x2*)(ap + 32));
          S[r] = MFMA16(f, vb[s2], S[r]);
        }
      }
    } else {
      f32x4 acco[2][NW];
#pragma unroll
      for (int ct = 0; ct < NW; ++ct) {
        bf16x8 sb[4];
#pragma unroll
        for (int s = 0; s < 4; ++s) sb[s] = *(const bf16x8*)(sbx + ((ct * 4 + s) * 64 + lane) * 16);
#pragma unroll
        for (int m = 0; m < 2; ++m) acco[m][ct] = f32x4{0.f, 0.f, 0.f, 0.f};
#pragma unroll
        for (int s = 0; s < 4; ++s)
#pragma unroll
          for (int m = 0; m < 2; ++m) acco[m][ct] = MFMA16(qfr[m][s], sb[s], acco[m][ct]);
      }
      if (n + 1 < NCH) qload(n + 1);
      __syncthreads();
      const int t0 = n * 64 - 48;
#pragma unroll
      for (int m = 0; m < 2; ++m) {
        const int mt = cw * 2 + m;
        bf16x8 qkf[2];
#pragma unroll
        for (int s2 = 0; s2 < 2; ++s2) {
          const char* a = qksm + (mt * 16 + l15) * 144 + s2 * 64 + quad * 8;
          qkf[s2] = mk8(*(const u32x2*)a, *(const u32x2*)(a + 32));
        }
        const f32x4 ge4 = *(const f32x4*)(gsm + mt * 16 + quad * 4);
#pragma unroll
        for (int ct = 0; ct < NW; ++ct) {
          f32x4 a2 = f32x4{0.f, 0.f, 0.f, 0.f};
#pragma unroll
          for (int s2 = 0; s2 < 2; ++s2) {
            const bf16x8 vb = *(const bf16x8*)(vbx + ((ct * 2 + s2) * 64 + lane) * 16);
            a2 = MFMA16(qkf[s2], vb, a2);
          }
#pragma unroll
          for (int jj = 0; jj < 4; ++jj) {
            const int t = t0 + mt * 16 + quad * 4 + jj;
            const float o = ge4[jj] * acco[m][ct][jj] + a2[jj];
            if (t >= 0) r1[(size_t)t * 3072 + 2048 + h * 128 + vb0 + ct * 16 + l15] = f2bf(o);
          }
        }
      }
    }
    __syncthreads();
  }
}

DEVI void gate_phase(const Params& p, int j) {
  bf16_t* r1 = (bf16_t*)(p.ws + OFF_R1);
  const bf16_t* z = (const bf16_t*)(p.ws + OFF_R0) + R0_Z;
  const float* nw = p.in[13] + j * 128;
  const int tid = TIDX;
  const int lane = tid & 63;
  const int gw = BIDX * 4 + (tid >> 6), nwv = gridDim.x * 4;
  const int half = lane >> 5, l31 = lane & 31;
  const f32x4 w = *(const f32x4*)(nw + l31 * 4);
  for (int t = gw; t < L; t += nwv) {
    u32x2 ov[4], zv[4];
#pragma unroll
    for (int q = 0; q < 4; ++q) {
      const int h = q * 2 + half;
      ov[q] = *(const u32x2*)(r1 + (size_t)t * 3072 + 2048 + h * 128 + l31 * 4);
      zv[q] = *(const u32x2*)(z + (size_t)t * 1024 + h * 128 + l31 * 4);
    }
    float ss[4];
#pragma unroll
    for (int q = 0; q < 4; ++q) {
      const float o0 = bflo(ov[q].x), o1 = bfhi(ov[q].x), o2 = bflo(ov[q].y), o3 = bfhi(ov[q].y);
      ss[q] = o0 * o0 + o1 * o1 + o2 * o2 + o3 * o3;
    }
#pragma unroll
    for (int m = 16; m >= 1; m >>= 1) {
#pragma unroll
      for (int q = 0; q < 4; ++q) ss[q] += __shfl_xor(ss[q], m);
    }
#pragma unroll
    for (int q = 0; q < 4; ++q) {
      const int h = q * 2 + half;
      const float r = rsqrtf(ss[q] * (1.f / 128.f) + 1e-6f);
      const float o[4] = {bflo(ov[q].x), bfhi(ov[q].x), bflo(ov[q].y), bfhi(ov[q].y)};
      const float zz[4] = {bflo(zv[q].x), bfhi(zv[q].x), bflo(zv[q].y), bfhi(zv[q].y)};
      float y[4];
#pragma unroll
      for (int e = 0; e < 4; ++e) y[e] = o[e] * r * w[e] * (zz[e] / (1.f + __expf(-zz[e])));
      *(u32x2*)(r1 + (size_t)t * 3072 + h * 128 + l31 * 4) = u32x2{pack2(y[0], y[1]), pack2(y[2], y[3])};
    }
  }
}


#define XB_TMO      128
#define XB_XCNT(j)  (256  + 64 * (j))
#define XB_XSUB(j)  (1280 + 64 * (j))
#define XB_XGEN(j)  (2304 + 64 * (j))
#define XB_TOP      3328
#define XB_TOPGEN   3392
#define XCD_BAR_WORDS 3456
#define XB_SPIN_CAP (1u << 20)
#define LAS __attribute__((address_space(3)))
DEVI unsigned xb_ld(unsigned* p) { return __hip_atomic_load(p, __ATOMIC_RELAXED, __HIP_MEMORY_SCOPE_AGENT); }
DEVI unsigned xb_add(unsigned* p, unsigned v) { return __hip_atomic_fetch_add(p, v, __ATOMIC_RELAXED, __HIP_MEMORY_SCOPE_AGENT); }
#define XB_SPIN(cond, bar) do { unsigned _sp = 0; while (cond) { __builtin_amdgcn_s_sleep(40); \
    if ((++_sp & 255u) == 0u) { if (xb_ld(&(bar)[XB_TMO])) break; if (_sp > XB_SPIN_CAP) { atomicAdd(&(bar)[XB_TMO], 1u); break; } } } } while (0)
struct XcdBarrier {
  unsigned* bar; unsigned x;
  volatile LAS unsigned* st;
};
DEVI XcdBarrier xcd_barrier_post(unsigned* bar, volatile LAS unsigned* st) {
  XcdBarrier b; b.bar = bar; b.x = xb_xcc_id(); b.st = st;
  if (threadIdx.x == 0) (void)xb_add(&bar[XB_XCNT(b.x)], 1u);
  return b;
}
DEVI void xcd_barrier_complete(unsigned* bar, unsigned x, unsigned& nloc, unsigned& nx) {
  const unsigned G = gridDim.x * gridDim.y * gridDim.z;
  unsigned sum, cnt, mine, sp = 0u;
  for (;;) {
    sum = 0u; cnt = 0u; mine = 0u;
#pragma unroll
    for (unsigned j = 0; j < 16; ++j) { const unsigned c = xb_ld(&bar[XB_XCNT(j)]); sum += c; cnt += (c > 0u) ? 1u : 0u; mine = (j == x) ? c : mine; }
    if (sum == G) break;
    __builtin_amdgcn_s_sleep(1);
    if ((++sp & 255u) == 0u) { if (xb_ld(&bar[XB_TMO])) break; if (sp > XB_SPIN_CAP) { atomicAdd(&bar[XB_TMO], 1u); break; } }
  }
  nloc = mine > 0u ? mine : 1u; nx = cnt > 0u ? cnt : 1u;
}
DEVI void xcd_barrier(const XcdBarrier& b) {
  asm volatile("s_waitcnt vmcnt(0)" ::: "memory");
  __syncthreads();
  if (threadIdx.x == 0) {
    unsigned* bar = b.bar;
    __builtin_amdgcn_s_waitcnt(0);
    unsigned nloc = b.st[0], nx = b.st[1];
    if (nloc == 0u) { xcd_barrier_complete(bar, b.x, nloc, nx); b.st[0] = nloc; b.st[1] = nx; }
    const unsigned old = xb_add(&bar[XB_XSUB(b.x)], 1u);
    const unsigned gen = old / nloc;
    if (old + 1u == (gen + 1u) * nloc) {
      __builtin_amdgcn_fence(__ATOMIC_RELEASE, "agent");
      asm volatile("s_waitcnt vmcnt(0)" ::: "memory");
      const unsigned og = xb_add(&bar[XB_TOP], 1u);
      const unsigned tg = og / nx;
      if (og + 1u == (tg + 1u) * nx) xb_add(&bar[XB_TOPGEN], 1u);
      else XB_SPIN(xb_ld(&bar[XB_TOPGEN]) == tg, bar);
      __builtin_amdgcn_fence(__ATOMIC_ACQUIRE, "agent");
      xb_add(&bar[XB_XGEN(b.x)], 1u);
      asm volatile("s_waitcnt vmcnt(0)" ::: "memory");
    } else {
      XB_SPIN(xb_ld(&bar[XB_XGEN(b.x)]) == gen, bar);
      __builtin_amdgcn_fence(__ATOMIC_ACQUIRE, "agent");
      asm volatile("s_waitcnt vmcnt(0)" ::: "memory");
    }
  }
  __syncthreads();
}

#ifndef ENABLE
#define ENABLE 0xFFFF
#endif
#define EN(bit) if constexpr ((ENABLE >> (bit)) & 1)
__global__ void __launch_bounds__(256, 2) mk(Params p_in, int ph_lo, int ph_hi) {
  extern __shared__ __attribute__((aligned(16))) char smem[];
  __shared__ uint4 sh_misc[2];
  int& s_item = *(int*)&sh_misc[1];
  cg::grid_group grid = cg::this_grid();
  if (threadIdx.x == 0) sh_misc[0] = make_uint4(0u, 0u, 0u, 0u);
  __syncthreads();
  const XcdBarrier xb = xcd_barrier_post((unsigned*)(p_in.ws + OFF_BAR), (volatile LAS unsigned*)&sh_misc[0]);
  grid.sync();
  for (int ph = ph_lo; ph < ph_hi; ++ph) {
    long zoff = 0;
    asm volatile("" : "+s"(zoff));
    Params p;
#pragma unroll
    for (int i = 0; i < 21; ++i) p.in[i] = (const float*)((GLOBAL_AS const float*)(p_in.in[i]));
    p.ws = (char*)((GLOBAL_AS char*)(p_in.ws + zoff));
    p.out = (float*)((GLOBAL_AS float*)(p_in.out + zoff));
    bf16_t* hb = (bf16_t*)(p.ws + OFF_HB);
    bf16_t* wb = (bf16_t*)(p.ws + OFF_WB);
    bf16_t* r0 = (bf16_t*)(p.ws + OFF_R0);
    bf16_t* r1 = (bf16_t*)(p.ws + OFF_R1);
    if (ph == 0) {
      EN(0) { init_phase(p); }
      EN(1) { convert_layer(p, 0, smem); }
    } else {
      const int layer = (ph - 1) / 10, sub = (ph - 1) % 10;
      const int j = layer >> 1;
      const bool even = (layer & 1) == 0;
      if (even && sub >= 3 && sub <= 5) continue;
      if (even) {
        if (sub == 0) {
          EN(2) { gemm_phase(hb, 1024, wb + WB_IN, 1024, 16, smem, EpiEvenIn{r0}); }
        } else if (sub == 1) {
          const float linit = 0.8f - 0.6f * expf(-0.3f * (float)layer);
          EN(4) { attn_phase(p, j, linit, smem, &s_item); }
        } else if (sub == 2) {
          EN(2) { gemm_phase(r1, 1024, wb + WB_OUT, 1024, 8, smem, EpiResid{p, layer == 0}); }
        }
      } else {
        if (sub == 0) {
          EN(2) { gemm_phase(hb, 1024, wb + WB_IN, 1024, 25, smem, EpiOddIn{r0, (float*)(p.ws + OFF_BA)}); }
        } else if (sub == 1) {
          EN(5) { conv_phase(p, j); }
        } else if (sub == 2) {
          EN(6) { for (int it = BIDX; it < NCH * 8; it += gridDim.x) prep_item(p, j, it >> 3, it & 7, smem); }
        } else if (sub == 3) {
          const int nitems = 8 * (8 / NW);
          if ((int)BIDX < nitems) {
            EN(7) { scan_item(p, BIDX & 7, BIDX >> 3, smem); }
          } else {
            EN(2) { gemm_phase(hb, 1024, wb + WB_Z, 1024, 8, smem, EpiZ{r0 + R0_Z}, nitems); }
          }
        } else if (sub == 4) {
          EN(8) { gate_phase(p, j); }
        } else if (sub == 5) {
          EN(2) { gemm_phase(r1, 3072, wb + WB_OUT, 1024, 8, smem, EpiResid{p, false}); }
        }
      }
      if (sub == 6) {
        EN(9) { ln_phase(p, p.in[17] + layer * 1024, p.in[18] + layer * 1024); }
      } else if (sub == 7) {
        EN(2) { gemm_phase(hb, 1024, wb + WB_W1, 1024, 32, smem, EpiSqRelu{r0}); }
      } else if (sub == 8) {
        EN(2) { gemm_phase(r0, 4096, wb + WB_W2, 4096, 8, smem, EpiResid{p, false}); }
      } else if (sub == 9) {
        EN(9) { ln_phase(p, p.in[19] + layer * 1024, p.in[20] + layer * 1024, layer < 3); }
        EN(1) { if (layer < 3) convert_layer(p, layer + 1, smem); }
      }
    }
    if (ph + 1 < ph_hi) xcd_barrier(xb);
  }
}

extern "C" void kernel_launch(void* const* d_in, const int* in_sizes, int n_in, void* d_out, int out_size,
                              void* d_ws, size_t ws_size, hipStream_t stream) {
  static int grid_blocks = 0;
  if (!grid_blocks) {
    int dev = 0, cus = 0, per_cu = 0;
    (void)hipGetDevice(&dev);
    (void)hipDeviceGetAttribute(&cus, hipDeviceAttributeMultiprocessorCount, dev);
    (void)hipFuncSetAttribute((const void*)mk, hipFuncAttributeMaxDynamicSharedMemorySize, SMEM_BYTES);
    (void)hipOccupancyMaxActiveBlocksPerMultiprocessor(&per_cu, mk, 256, SMEM_BYTES);
    if (per_cu > 2) per_cu = 2;
    if (per_cu < 1) per_cu = 1;
    grid_blocks = cus * per_cu;
  }
  Params p{};
  for (int i = 0; i < 21; ++i) p.in[i] = (const float*)d_in[i];
  p.out = (float*)d_out;
  p.ws = (char*)d_ws;
  int lo = 0, hi = 41;
  void* args[] = {&p, &lo, &hi};
  (void)hipMemsetAsync((char*)d_ws + OFF_BAR, 0, 16384, stream);
  (void)hipLaunchCooperativeKernel((void*)mk, dim3(grid_blocks), dim3(256), args, SMEM_BYTES, stream);
}
```
